# Optimizing an MI355X kernel written in HIP

```python
import jax, jax.numpy as jnp
from jax import lax
import numpy as np

D_MODEL = 1024
BATCH = 2
SEQ = 16384
DEPTH = 4

MEM_LEN = 256
N_HEADS_MLA = 8
QK_NOPE_DIM = 64
QK_ROPE_DIM = 32
QK_HEAD_DIM = QK_NOPE_DIM + QK_ROPE_DIM
V_HEAD_DIM = 64
Q_LORA_RANK = 3 * D_MODEL // 8
KV_LORA_RANK = D_MODEL // 4
MLA_WIDTH = N_HEADS_MLA * V_HEAD_DIM
CONV_WIDTH = D_MODEL // 2
CONV_K = 3
N_HEADS_MEM = 4
MEM_HEAD_DIM = 128
MEM_WIDTH = N_HEADS_MEM * MEM_HEAD_DIM

N_BRANCH = 3
ROPE_BASE = 10000.0
Q_BLOCK = 128
EPS = 1e-6

IN_SIZES = (Q_LORA_RANK, KV_LORA_RANK, QK_ROPE_DIM,
            CONV_WIDTH, CONV_WIDTH, CONV_WIDTH,
            MEM_WIDTH,
            MLA_WIDTH, CONV_WIDTH, MEM_WIDTH,
            N_BRANCH * D_MODEL)
IN_WIDTH = sum(IN_SIZES)

kernel_name = 'hybrid_mla_shortconv_memxattn_encoder'


def rmsnorm(t, g):
    tf = t.astype(jnp.float32)
    tf = tf * lax.rsqrt(jnp.mean(tf * tf, axis=-1, keepdims=True) + EPS)
    return tf.astype(t.dtype) * g


def split_cols(t, sizes):
    return jnp.split(t, np.cumsum(sizes)[:-1].tolist(), axis=-1)


def rope_tables(positions, dtype):
    inv_freq = ROPE_BASE ** (-jnp.arange(0, QK_ROPE_DIM, 2, dtype=jnp.float32) / QK_ROPE_DIM)
    ang = positions.astype(jnp.float32)[..., None] * inv_freq
    return (jnp.cos(ang)[:, :, None, :].astype(dtype),
            jnp.sin(ang)[:, :, None, :].astype(dtype))


def rope_tail(t, cos, sin):
    t_nope, t1, t2 = split_cols(t, (QK_NOPE_DIM, QK_ROPE_DIM // 2, QK_ROPE_DIM // 2))
    return jnp.concatenate([t_nope, t1 * cos - t2 * sin, t2 * cos + t1 * sin], axis=-1)


def blocked_bidirectional_attention(q, k, v):
    B, S, H, Dh = q.shape
    nblk = S // Q_BLOCK
    qb = q.reshape(B, nblk, Q_BLOCK, H, Dh).transpose(1, 0, 2, 3, 4)
    scale = Dh ** -0.5

    def one_block(q_blk):
        s = jnp.einsum('bqhd,bkhd->bhqk', q_blk, k).astype(jnp.float32) * scale
        p = jax.nn.softmax(s, axis=-1).astype(v.dtype)
        return jnp.einsum('bhqk,bkhd->bqhd', p, v)

    out = lax.map(one_block, qb)
    return out.transpose(1, 0, 2, 3, 4).reshape(B, S, H * v.shape[-1])


def centred_short_conv(z, w, b):
    out = lax.conv_general_dilated(
        z, w[:, None, :], window_strides=(1,),
        padding=((CONV_K // 2, CONV_K // 2),),
        dimension_numbers=('NWC', 'WIO', 'NWC'),
        feature_group_count=z.shape[-1])
    return out + b


def hybrid_layer(x, mem, cos, sin, norm_g, w_in, b_gate, q_norm_g, w_uq, kv_norm_g, w_ukv,
                 q_head_g, k_head_g, conv_w, conv_b, mem_norm_g, w_mkv, mem_q_g, mem_k_g,
                 w_br_attn, w_br_conv, w_br_mem, w_out):
    B, S, _ = x.shape
    M = mem.shape[1]
    h = rmsnorm(x, norm_g)
    proj = h @ w_in
    (q_lat, kv_lat, k_pe, c_b, c_c, c_u, q_mem,
     g_attn, g_conv, g_mem, r) = split_cols(proj, IN_SIZES)

    q = (rmsnorm(q_lat, q_norm_g) @ w_uq).reshape(B, S, N_HEADS_MLA, QK_HEAD_DIM)
    kv = (rmsnorm(kv_lat, kv_norm_g) @ w_ukv).reshape(B, S, N_HEADS_MLA, QK_NOPE_DIM + V_HEAD_DIM)
    k_nope, v = split_cols(kv, (QK_NOPE_DIM, V_HEAD_DIM))
    k_rope = jnp.broadcast_to(k_pe[:, :, None, :], (B, S, N_HEADS_MLA, QK_ROPE_DIM))
    k = jnp.concatenate([k_nope, k_rope], axis=-1)
    q = rope_tail(rmsnorm(q, q_head_g), cos, sin)
    k = rope_tail(rmsnorm(k, k_head_g), cos, sin)
    o_attn = blocked_bidirectional_attention(q, k, v) * jax.nn.silu(g_attn)

    o_conv = c_b * centred_short_conv(c_c * c_u, conv_w, conv_b) * jax.nn.silu(g_conv)

    mkv = (rmsnorm(mem, mem_norm_g) @ w_mkv).reshape(B, M, N_HEADS_MEM, 2 * MEM_HEAD_DIM)
    m_k, m_v = split_cols(mkv, (MEM_HEAD_DIM, MEM_HEAD_DIM))
    mq = rmsnorm(q_mem.reshape(B, S, N_HEADS_MEM, MEM_HEAD_DIM), mem_q_g)
    m_k = rmsnorm(m_k, mem_k_g)
    s = jnp.einsum('bshd,bmhd->bhsm', mq, m_k).astype(jnp.float32) * (MEM_HEAD_DIM ** -0.5)
    p = jax.nn.softmax(s, axis=-1).astype(m_v.dtype)
    o_mem = jnp.einsum('bhsm,bmhd->bshd', p, m_v).reshape(B, S, MEM_WIDTH) * jax.nn.silu(g_mem)

    r_attn, r_conv, r_mem = split_cols(jax.nn.sigmoid(r + b_gate), (D_MODEL, D_MODEL, D_MODEL))
    y = r_attn * (o_attn @ w_br_attn) + r_conv * (o_conv @ w_br_conv) + r_mem * (o_mem @ w_br_mem)
    return x + y @ w_out


def setup_inputs(seed: int = 0) -> dict:
    key = jax.random.key(seed)
    ks = jax.random.split(key, 24)

    def nrm(k, shape, scale):
        return jax.random.normal(k, shape, jnp.float32) * scale

    def gain(k, shape):
        return 1.0 + 0.1 * jax.random.normal(k, shape, jnp.float32)

    x = nrm(ks[0], (BATCH, SEQ, D_MODEL), 1.0)
    mem = nrm(ks[1], (BATCH, MEM_LEN, D_MODEL), 1.0)
    offset = jax.random.randint(ks[2], (BATCH, 1), 0, 1024, dtype=jnp.int32)
    positions = jnp.arange(SEQ, dtype=jnp.int32)[None, :] + offset
    return {
        'x': x,
        'mem': mem,
        'positions': positions,
        'norm_g': gain(ks[3], (DEPTH, D_MODEL)),
        'w_in': nrm(ks[4], (DEPTH, D_MODEL, IN_WIDTH), D_MODEL ** -0.5),
        'b_gate': nrm(ks[5], (DEPTH, N_BRANCH * D_MODEL), 0.1),
        'q_norm_g': gain(ks[6], (DEPTH, Q_LORA_RANK)),
        'w_uq': nrm(ks[7], (DEPTH, Q_LORA_RANK, N_HEADS_MLA * QK_HEAD_DIM), Q_LORA_RANK ** -0.5),
        'kv_norm_g': gain(ks[8], (DEPTH, KV_LORA_RANK)),
        'w_ukv': nrm(ks[9], (DEPTH, KV_LORA_RANK, N_HEADS_MLA * (QK_NOPE_DIM + V_HEAD_DIM)), KV_LORA_RANK ** -0.5),
        'q_head_g': gain(ks[10], (DEPTH, QK_HEAD_DIM)),
        'k_head_g': gain(ks[11], (DEPTH, QK_HEAD_DIM)),
        'conv_w': nrm(ks[12], (DEPTH, CONV_K, CONV_WIDTH), CONV_K ** -0.5),
        'conv_b': nrm(ks[13], (DEPTH, CONV_WIDTH), 0.1),
        'mem_norm_g': gain(ks[14], (DEPTH, D_MODEL)),
        'w_mkv': nrm(ks[15], (DEPTH, D_MODEL, 2 * MEM_WIDTH), D_MODEL ** -0.5),
        'mem_q_g': gain(ks[16], (DEPTH, MEM_HEAD_DIM)),
        'mem_k_g': gain(ks[17], (DEPTH, MEM_HEAD_DIM)),
        'w_br_attn': nrm(ks[18], (DEPTH, MLA_WIDTH, D_MODEL), MLA_WIDTH ** -0.5),
        'w_br_conv': nrm(ks[19], (DEPTH, CONV_WIDTH, D_MODEL), CONV_WIDTH ** -0.5),
        'w_br_mem': nrm(ks[20], (DEPTH, MEM_WIDTH, D_MODEL), MEM_WIDTH ** -0.5),
        'w_out': nrm(ks[21], (DEPTH, D_MODEL, D_MODEL), D_MODEL ** -0.5),
    }


def reference(x, mem, positions, norm_g, w_in, b_gate, q_norm_g, w_uq, kv_norm_g, w_ukv,
              q_head_g, k_head_g, conv_w, conv_b, mem_norm_g, w_mkv, mem_q_g, mem_k_g,
              w_br_attn, w_br_conv, w_br_mem, w_out):
    cos, sin = rope_tables(positions, x.dtype)
    for i in range(DEPTH):
        x = hybrid_layer(x, mem, cos, sin, norm_g[i], w_in[i], b_gate[i], q_norm_g[i], w_uq[i],
                         kv_norm_g[i], w_ukv[i], q_head_g[i], k_head_g[i], conv_w[i], conv_b[i],
                         mem_norm_g[i], w_mkv[i], mem_q_g[i], mem_k_g[i],
                         w_br_attn[i], w_br_conv[i], w_br_mem[i], w_out[i])
    return x
```

```cpp
#include <hip/hip_runtime.h>
#include <hip/hip_cooperative_groups.h>
#include <cstdio>
#include <cstdint>
#include <cmath>
namespace cg = cooperative_groups;

#ifndef EN_MASK
#define EN_MASK 0xFFFF
#endif
#define EN(i) ((EN_MASK >> (i)) & 1)
#ifndef MK_MULTI
#define MK_MULTI 0
#endif

constexpr int DM = 1024, NB = 2, SEQ = 16384, DEPTH = 4, MEML = 256;
constexpr int NH = 8, QLR = 384, KVLR = 256;
constexpr int INW = 7328, PJ = 7424;
constexpr float EPS = 1e-6f;
constexpr int LDS_SCR_OFF = 132224;
constexpr int C_RATTN = 0, C_RCONV = 1024, C_RMEM = 2048, C_GATTN = 3072, C_GCONV = 3584, C_GMEM = 4096, C_CB = 4608, C_CC = 5120, C_CU = 5632,
              C_QMEM = 6144, C_KVLAT = 6656, C_QLAT = 6912, C_KPE = 7296;
constexpr size_t MiB = 1u << 20;
constexpr size_t SZ_WIN = (size_t)PJ * 1024 * 2, SZ_WUQ = 768 * 384 * 2, SZ_WUKV = 1024 * 256 * 2, SZ_WBR = 1024 * 512 * 2, SZ_WOUT = 1024 * 1024 * 2;
constexpr size_t LW_WIN = 0, LW_WUQ = LW_WIN + SZ_WIN, LW_WUKV = LW_WUQ + SZ_WUQ, LW_WBA = LW_WUKV + SZ_WUKV, LW_WBC = LW_WBA + SZ_WBR, LW_WBM = LW_WBC + SZ_WBR,
                 LW_WOUT = LW_WBM + SZ_WBR, LW_SIZE = LW_WOUT + SZ_WOUT;
constexpr size_t WS_LW = 0;
constexpr size_t WS_WMKV = ((WS_LW + 4 * LW_SIZE + 4095) / 4096) * 4096;
constexpr size_t WS_MEMB = WS_WMKV + 8 * MiB;
constexpr size_t WS_MKVRAW = WS_MEMB + 1 * MiB;
constexpr size_t WS_MK = WS_MKVRAW + 4 * MiB;
constexpr size_t WS_MV = WS_MK + 2 * MiB;
constexpr size_t WS_MRSTD = WS_MV + 2 * MiB;
constexpr size_t WS_RSTD = WS_MRSTD + 4096;
constexpr size_t WS_XB = WS_RSTD + 65536;
constexpr size_t WS_PROJ = WS_XB + 32 * MiB;
constexpr size_t WS_QRAW = WS_PROJ + (size_t)SEQ * PJ * 2;
constexpr size_t WS_KVRAW = WS_QRAW + 24 * MiB;
constexpr size_t WS_QF = WS_KVRAW + 32 * MiB;
constexpr size_t WS_KF = WS_QF + 24 * MiB;
constexpr size_t WS_VF = WS_KF + 24 * MiB;
constexpr size_t WS_BAR = WS_VF + 16 * MiB;
constexpr size_t WS_QN = WS_BAR + 16384;
constexpr size_t WS_KQMAX = WS_QN + (size_t)SEQ * 8 * 4;
constexpr size_t WS_END = WS_KQMAX + 256;

typedef unsigned short bf16_t;
typedef short bf16x8 __attribute__((ext_vector_type(8)));
typedef short s16x4 __attribute__((ext_vector_type(4)));
typedef float f32x4 __attribute__((ext_vector_type(4)));
typedef float f32x16 __attribute__((ext_vector_type(16)));
typedef unsigned u32x4 __attribute__((ext_vector_type(4)));
typedef unsigned u32x2 __attribute__((ext_vector_type(2)));
#define LAS __attribute__((address_space(3)))

__device__ __forceinline__ unsigned cvtpk(float lo, float hi) { unsigned r; asm volatile("v_cvt_pk_bf16_f32 %0, %1, %2" : "=v"(r) : "v"(lo), "v"(hi)); return r; }
__device__ __forceinline__ float bflo(unsigned w) { return __uint_as_float(w << 16); }
__device__ __forceinline__ float bfhi(unsigned w) { return __uint_as_float(w & 0xffff0000u); }
__device__ __forceinline__ float bf1(bf16_t h) { return __uint_as_float(((unsigned)h) << 16); }
__device__ __forceinline__ float siluf_(float v) { return v * __builtin_amdgcn_rcpf(1.f + __builtin_amdgcn_exp2f(-1.4426950408889634f * v)); }
__device__ __forceinline__ float sigmoidf_(float v) { return __builtin_amdgcn_rcpf(1.f + __builtin_amdgcn_exp2f(-1.4426950408889634f * v)); }
template <int CTRL> __device__ __forceinline__ float dpp_mov(float v) { return __uint_as_float((unsigned)__builtin_amdgcn_update_dpp(0, (int)__float_as_uint(v), CTRL, 0xF, 0xF, true)); }
__device__ __forceinline__ float sum8(float v) { v += dpp_mov<0xB1>(v); v += dpp_mov<0x4E>(v); v += dpp_mov<0x141>(v); return v; }
__device__ __forceinline__ float sum16(float v) { v = sum8(v); v += dpp_mov<0x140>(v); return v; }
__device__ __forceinline__ float wave_sum(float v) {
    v = sum16(v);
    const float a = __uint_as_float((unsigned)__builtin_amdgcn_readlane((int)__float_as_uint(v), 0)), b = __uint_as_float((unsigned)__builtin_amdgcn_readlane((int)__float_as_uint(v), 16));
    const float c = __uint_as_float((unsigned)__builtin_amdgcn_readlane((int)__float_as_uint(v), 32)), d = __uint_as_float((unsigned)__builtin_amdgcn_readlane((int)__float_as_uint(v), 48));
    return (a + b) + (c + d);
}
__device__ __forceinline__ float sumsq8(u32x4 w) {
    float s = 0.f;
#pragma unroll
    for (int i = 0; i < 4; ++i) { const float a = bflo(w[i]), b = bfhi(w[i]); s += a * a + b * b; }
    return s;
}

namespace pg8 {
constexpr int BM = 256, BK = 64, HALF = 128, HTB = HALF * BK * 2, STAGE_BYTES = 8 * HTB, NXCD = 8, WGM = 4;
__host__ __device__ __forceinline__ int lds_byte(int r, int c) { const int st = (r >> 4) * 2 + (c >> 5), rr = r & 15, cc = c & 31, ob = rr * 64 + cc * 2; return st * 1024 + (ob ^ (((ob >> 9) & 1) << 5)); }
__host__ __device__ __forceinline__ void stage_rc(int b, int& R, int& C) { const int st = b / 1024, sb = b % 1024, swz = sb ^ (((sb >> 9) & 1) << 5); R = (st >> 1) * 16 + swz / 64; C = (st & 1) * 32 + (swz % 64) / 2; }
__host__ __device__ __forceinline__ int perm32(int rho) { const int n = rho >> 4, i = rho & 15; return 8 * (i >> 2) + 4 * n + (i & 3); }
struct Unit { int pm, pn; };
struct Gemm { const bf16_t* A; const bf16_t* Bt; int M, N, K, lda; };
struct StaticOrder {
    int nM, nN, nwg, G, c;
    __device__ void init(int M, int N, int G_, int c_) { nM = M / BM; nN = N / BM; nwg = nM * nN; G = G_; c = c_; }
    __device__ bool next(int i, Unit& u) const {
        const long L = (long)i * G + c; if (L >= nwg) return false;
        int wgid = (int)L; { const int q = nwg / NXCD, r = nwg % NXCD, xcd = wgid % NXCD, off = wgid / NXCD; wgid = (xcd < r ? xcd * (q + 1) : r * (q + 1) + (xcd - r) * q) + off; }
        const int nig = WGM * nN, gid = wgid / nig, fm = gid * WGM, gsz = (nM - fm) < WGM ? (nM - fm) : WGM;
        u.pm = fm + ((wgid % nig) % gsz); u.pn = (wgid % nig) / gsz; return true;
    }
};
struct EpiRT {
    static constexpr bool PERM = true;
    int mode; bf16_t* O; int ldc; const float* rstd; const float* bias; const bf16_t* R; const float* Xin; float* Xout;
    __device__ __forceinline__ void operator()(const f32x4 (&acc)[2][2][4][2], const Unit& u, int wr, int wc, int fr, int fq) const {
        const int row0 = u.pm * BM + wr * 64 + fr, col0 = u.pn * BM + wc * 32 + 8 * fq;
        const int kind = (mode == 1 && u.pn < 12) ? 0 : 2;
        f32x4 bv[2][2];
#pragma unroll
        for (int bj = 0; bj < 2; ++bj) { bv[bj][0] = (f32x4){0.f, 0.f, 0.f, 0.f}; bv[bj][1] = bv[bj][0];
            if (kind == 0) { bv[bj][0] = *(const f32x4*)(bias + col0 + bj * HALF) * -1.4426950408889634f; bv[bj][1] = *(const f32x4*)(bias + col0 + bj * HALF + 4) * -1.4426950408889634f; } }
#pragma unroll
        for (int ai = 0; ai < 2; ++ai)
#pragma unroll
            for (int mp = 0; mp < 2; ++mp) {
                float rs[2]; u32x4 t0[2][2], t1[2][2];
#pragma unroll
                for (int mm = 0; mm < 2; ++mm) { const int row = row0 + ai * HALF + (2 * mp + mm) * 16;
                    rs[mm] = rstd ? rstd[row] : 1.f;
#pragma unroll
                    for (int bj = 0; bj < 2; ++bj) {
                        if (mode == 4) { const size_t off = (size_t)row * 1024 + col0 + bj * HALF; t0[mm][bj] = *(const u32x4*)(Xin + off); t1[mm][bj] = *(const u32x4*)(Xin + off + 4); }
                        else if (mode >= 2) { t0[mm][bj] = *(const u32x4*)(R + (size_t)row * ldc + col0 + bj * HALF);
                            if (mode == 3) t1[mm][bj] = *(const u32x4*)(O + (size_t)row * ldc + col0 + bj * HALF); } } }
#pragma unroll
                for (int mm = 0; mm < 2; ++mm) { const int m = 2 * mp + mm; const int row = row0 + ai * HALF + m * 16;
#pragma unroll
                    for (int bj = 0; bj < 2; ++bj) {
                        f32x4 v0 = acc[ai][bj][m][0], v1 = acc[ai][bj][m][1];
                        if (mode == 4) {
                            const size_t off = (size_t)row * 1024 + col0 + bj * HALF;
                            const u32x4 qa = t0[mm][bj], qb = t1[mm][bj];
                            *(f32x4*)(Xout + off) = (f32x4){__uint_as_float(qa.x), __uint_as_float(qa.y), __uint_as_float(qa.z), __uint_as_float(qa.w)} + v0;
                            *(f32x4*)(Xout + off + 4) = (f32x4){__uint_as_float(qb.x), __uint_as_float(qb.y), __uint_as_float(qb.z), __uint_as_float(qb.w)} + v1;
                        } else {
                            if (kind == 0) {
                                const float nrs = rs[mm] * -1.4426950408889634f;
#pragma unroll
                                for (int e = 0; e < 4; ++e) { v0[e] = __builtin_amdgcn_rcpf(1.f + __builtin_amdgcn_exp2f(fmaf(v0[e], nrs, bv[bj][0][e]))); v1[e] = __builtin_amdgcn_rcpf(1.f + __builtin_amdgcn_exp2f(fmaf(v1[e], nrs, bv[bj][1][e]))); }
                            } else { v0 = v0 * rs[mm]; v1 = v1 * rs[mm]; }
                            bf16_t* op = O + (size_t)row * ldc + col0 + bj * HALF;
                            if (mode == 2 || mode == 3) { const u32x4 q = t0[mm][bj];
                                v0[0] *= bflo(q[0]); v0[1] *= bfhi(q[0]); v0[2] *= bflo(q[1]); v0[3] *= bfhi(q[1]);
                                v1[0] *= bflo(q[2]); v1[1] *= bfhi(q[2]); v1[2] *= bflo(q[3]); v1[3] *= bfhi(q[3]);
                                if (mode == 3) { const u32x4 y = t1[mm][bj];
                                    v0[0] += bflo(y[0]); v0[1] += bfhi(y[0]); v0[2] += bflo(y[1]); v0[3] += bfhi(y[1]);
                                    v1[0] += bflo(y[2]); v1[1] += bfhi(y[2]); v1[2] += bflo(y[3]); v1[3] += bfhi(y[3]); } }
                            u32x4 w; w.x = cvtpk(v0[0], v0[1]); w.y = cvtpk(v0[2], v0[3]); w.z = cvtpk(v1[0], v1[1]); w.w = cvtpk(v1[2], v1[3]);
                            *(u32x4*)op = w;
                        }
                    } }
                asm volatile("" ::: "memory");
            }
    }
};

template <class EpiT>
__device__ __forceinline__ void gemm_phase(LAS unsigned char* lds, const Gemm g, const StaticOrder& S, const EpiT& E, const int tid) {
    const int wid = __builtin_amdgcn_readfirstlane(tid >> 6), lane = tid & 63, wr = wid >> 2, wc = wid & 3, fr = lane & 15, fq = lane >> 4;
    const int K = g.K, nt = K / BK;
    unsigned voffA[2], voffB[2];
#pragma unroll
    for (int i = 0; i < 2; ++i) { int R, C; stage_rc(tid * 16 + i * 8192, R, C); const int Rb = EpiT::PERM ? ((R & ~31) + perm32(R & 31)) : R;
        voffA[i] = (unsigned)(R * g.lda + C) * 2u; voffB[i] = (unsigned)(Rb * K + C) * 2u; }
    const size_t kstep = (size_t)(BK * 2);
    const size_t hstepA = (size_t)HALF * g.lda * 2, hstepB = (size_t)HALF * K * 2;
    const size_t tstepA = 2 * hstepA, tstepB = 2 * hstepB;
    const unsigned ldsw = (unsigned)wid * 1024u;
    const int aoff = lds_byte(wr * 64 + fr, fq * 8), boff = lds_byte(wc * 32 + fr, fq * 8);
#define PG8_SA(b, h) (((b) * 2 + (h)) * HTB)
#define PG8_SB(b, h) ((4 + (b) * 2 + (h)) * HTB)
#define PG8_STAGE(bufoff, gbase, voff) do { _Pragma("unroll") for (int _i = 0; _i < 2; ++_i) \
        __builtin_amdgcn_global_load_lds((const unsigned*)((const char*)(gbase) + (voff)[_i]), (LAS unsigned*)(lds + (bufoff) + ldsw + _i * 8192), 16, 0, 0); } while (0)
#define PG8_LDA(dst, b, h) do { _Pragma("unroll") for (int m = 0; m < 4; ++m) _Pragma("unroll") for (int k = 0; k < 2; ++k) dst[m][k] = *(const LAS bf16x8*)(lds + PG8_SA(b, h) + aoff + m * 2048 + k * 1024); } while (0)
#define PG8_LDB(dst, b, h) do { _Pragma("unroll") for (int n = 0; n < 2; ++n) _Pragma("unroll") for (int k = 0; k < 2; ++k) dst[n][k] = *(const LAS bf16x8*)(lds + PG8_SB(b, h) + boff + n * 2048 + k * 1024); } while (0)
#define PG8_MMA(ai, bj, At, Bt) do { __builtin_amdgcn_s_setprio(1); _Pragma("unroll") for (int m = 0; m < 4; ++m) _Pragma("unroll") for (int n = 0; n < 2; ++n) _Pragma("unroll") for (int k = 0; k < 2; ++k) \
        acc[ai][bj][m][n] = __builtin_amdgcn_mfma_f32_16x16x32_bf16(Bt[n][k], At[m][k], acc[ai][bj][m][n], 0, 0, 0); __builtin_amdgcn_s_setprio(0); } while (0)
#define PG8_WAIT_V(n) asm volatile("s_waitcnt vmcnt(" #n ")" ::: "memory")
#define PG8_WAIT_L(n) asm volatile("s_waitcnt lgkmcnt(" #n ")" ::: "memory")
#define PG8_BAR __builtin_amdgcn_s_barrier()
#define PG8_SCHED __builtin_amdgcn_sched_barrier(0)
    Unit cur, nxt; int ui = 0;
    if (!S.next(0, cur)) return;
    f32x4 acc[2][2][4][2];
#pragma unroll
    for (int a = 0; a < 2; ++a)
#pragma unroll
        for (int b = 0; b < 2; ++b)
#pragma unroll
            for (int m = 0; m < 4; ++m)
#pragma unroll
                for (int n = 0; n < 2; ++n) acc[a][b][m][n] = (f32x4){0.f, 0.f, 0.f, 0.f};
    bf16x8 At[4][2], B0[2][2], B1[2][2];
    const char* cA = (const char*)g.A + (size_t)cur.pm * tstepA; const char* cB = (const char*)g.Bt + (size_t)cur.pn * tstepB;
    PG8_STAGE(PG8_SB(0, 0), cB, voffB); PG8_STAGE(PG8_SB(0, 1), cB + hstepB, voffB); PG8_STAGE(PG8_SA(0, 0), cA, voffA); PG8_STAGE(PG8_SA(0, 1), cA + hstepA, voffA);
    if (wr == 1) PG8_BAR;
    PG8_WAIT_V(2); PG8_BAR;
    PG8_STAGE(PG8_SB(1, 0), cB + kstep, voffB); PG8_STAGE(PG8_SA(1, 0), cA + kstep, voffA); PG8_STAGE(PG8_SB(1, 1), cB + hstepB + kstep, voffB);
    PG8_WAIT_V(6); PG8_BAR;
    for (;;) {
        const bool has_next = S.next(ui + 1, nxt);
        const char* nA = has_next ? (const char*)g.A + (size_t)nxt.pm * tstepA : cA; const char* nB = has_next ? (const char*)g.Bt + (size_t)nxt.pn * tstepB : cB;
        for (int t = 0; t < nt; t += 2) {
            const bool last = (t == nt - 2);
            const char* a1 = cA + (size_t)(t + 1) * kstep;
            const char* a2 = last ? nA : cA + (size_t)(t + 2) * kstep; const char* b2 = last ? nB : cB + (size_t)(t + 2) * kstep;
            const char* a3 = a2 + kstep; const char* b3 = b2 + kstep;
            PG8_LDB(B0, 0, 0); PG8_LDB(B1, 0, 1); PG8_SCHED; PG8_LDA(At, 0, 0); PG8_STAGE(PG8_SA(1, 1), a1 + hstepA, voffA);
            PG8_WAIT_V(8); PG8_WAIT_L(0); PG8_BAR; PG8_MMA(0, 0, At, B0); PG8_MMA(0, 1, At, B1); PG8_BAR; PG8_SCHED;
            PG8_LDA(At, 0, 1); PG8_STAGE(PG8_SB(0, 0), b2, voffB); PG8_STAGE(PG8_SB(0, 1), b2 + hstepB, voffB); PG8_STAGE(PG8_SA(0, 0), a2, voffA);
            PG8_WAIT_V(8); PG8_WAIT_L(0); PG8_BAR; PG8_MMA(1, 0, At, B0); PG8_MMA(1, 1, At, B1); PG8_BAR; PG8_SCHED;
            PG8_LDB(B0, 1, 0); PG8_LDB(B1, 1, 1); PG8_SCHED; PG8_LDA(At, 1, 0); PG8_STAGE(PG8_SA(0, 1), a2 + hstepA, voffA);
            PG8_WAIT_V(8); PG8_WAIT_L(0); PG8_BAR; PG8_MMA(0, 0, At, B0); PG8_MMA(0, 1, At, B1); PG8_BAR; PG8_SCHED;
            PG8_LDA(At, 1, 1); PG8_STAGE(PG8_SB(1, 0), b3, voffB); PG8_STAGE(PG8_SB(1, 1), b3 + hstepB, voffB); PG8_STAGE(PG8_SA(1, 0), a3, voffA);
            PG8_WAIT_V(8); PG8_WAIT_L(0); PG8_BAR; PG8_MMA(1, 0, At, B0); PG8_MMA(1, 1, At, B1); PG8_BAR; PG8_SCHED;
        }
        if (wr == 0) PG8_BAR;
        E(acc, cur, wr, wc, fr, fq);
        if (!has_next) break;
#pragma unroll
        for (int a = 0; a < 2; ++a)
#pragma unroll
            for (int b = 0; b < 2; ++b)
#pragma unroll
                for (int m = 0; m < 4; ++m)
#pragma unroll
                    for (int n = 0; n < 2; ++n) acc[a][b][m][n] = (f32x4){0.f, 0.f, 0.f, 0.f};
        cur = nxt; cA = nA; cB = nB; ++ui;
        if (wr == 1) PG8_BAR;
    }
    PG8_WAIT_V(0);
    PG8_BAR;
#undef PG8_SA
#undef PG8_SB
#undef PG8_STAGE
#undef PG8_LDA
#undef PG8_LDB
#undef PG8_MMA
#undef PG8_WAIT_V
#undef PG8_WAIT_L
#undef PG8_BAR
#undef PG8_SCHED
}
}

namespace att {
constexpr int NW = 8, QBLK = 32, KVBLK = 64;
constexpr float THR = 8.f;
constexpr int SHM_K = KVBLK * 256;
#define KSWZ(row, colB) ((row) * 256 + ((colB) ^ ((((row) & 7) | ((((row) >> 4) & 1) << 3)) << 4)))
#define SBAR() __builtin_amdgcn_sched_barrier(0)
__device__ __forceinline__ int crow(int r, int hi) { return (r & 3) + 8 * (r >> 2) + 4 * hi; }
template <int DQ> struct Sc { static constexpr float SCALE = (DQ == 96) ? 0.10206207261596575f : 0.08838834764831845f; };

template <int DQ, bool PRE>
__device__ __forceinline__ void partialSM(f32x16& p0, f32x16& p1, float& m_reg, float& mn, float& alpha) {
    constexpr float SCALE = PRE ? 0.6931471805599453f : Sc<DQ>::SCALE, C = SCALE * 1.4426950408889634f;
    float pmax = p0[0];
#pragma unroll
    for (int r = 1; r < 16; ++r) pmax = fmaxf(pmax, p0[r]);
#pragma unroll
    for (int r = 0; r < 16; ++r) pmax = fmaxf(pmax, p1[r]);
    { auto rr = __builtin_amdgcn_permlane32_swap(__float_as_uint(pmax), __float_as_uint(pmax), false, false);
      pmax = fmaxf(__uint_as_float(rr[0]), __uint_as_float(rr[1])); }
    if (__builtin_expect(__all(pmax - m_reg <= THR / SCALE), 1)) { mn = m_reg; alpha = 1.f; }
    else { mn = fmaxf(m_reg, pmax); alpha = __builtin_amdgcn_exp2f((m_reg - mn) * C); m_reg = mn; }
    const float mnC = -mn * C;
#pragma unroll
    for (int r = 0; r < 16; ++r) p0[r] = fmaf(p0[r], C, mnC);
#pragma unroll
    for (int r = 0; r < 16; ++r) p1[r] = fmaf(p1[r], C, mnC);
#pragma unroll
    for (int r = 0; r < 16; ++r) p0[r] = __builtin_amdgcn_exp2f(p0[r]);
}
__device__ __forceinline__ void finishSM(f32x16& p0, f32x16& p1, float alpha, float& l_reg, bf16x8& pa0, bf16x8& pa1, bf16x8& pa2, bf16x8& pa3) {
#pragma unroll
    for (int r = 0; r < 16; ++r) p1[r] = __builtin_amdgcn_exp2f(p1[r]);
    float ps = 0;
#pragma unroll
    for (int r = 0; r < 16; ++r) ps += p0[r];
#pragma unroll
    for (int r = 0; r < 16; ++r) ps += p1[r];
    { auto rr = __builtin_amdgcn_permlane32_swap(__float_as_uint(ps), __float_as_uint(ps), false, false);
      ps = __uint_as_float(rr[0]) + __uint_as_float(rr[1]); }
    l_reg = l_reg * alpha + ps;
#define PK4(P, BASE, OUT) do { unsigned a0 = cvtpk(P[BASE + 0], P[BASE + 1]), a1 = cvtpk(P[BASE + 2], P[BASE + 3]);   \
    unsigned b0 = cvtpk(P[BASE + 4], P[BASE + 5]), b1 = cvtpk(P[BASE + 6], P[BASE + 7]);                              \
    auto r0 = __builtin_amdgcn_permlane32_swap(a0, b0, false, false); auto r1 = __builtin_amdgcn_permlane32_swap(a1, b1, false, false); \
    u32x4 w = {r0[0], r1[0], r0[1], r1[1]}; OUT = *reinterpret_cast<bf16x8*>(&w); } while (0)
    PK4(p0, 0, pa0); PK4(p0, 8, pa1); PK4(p1, 0, pa2); PK4(p1, 8, pa3);
#undef PK4
}
__device__ __forceinline__ void fastSM0(f32x16& p0) {
#pragma unroll
    for (int r = 0; r < 16; ++r) p0[r] = __builtin_amdgcn_exp2f(p0[r]);
}
template <int DQ>
__device__ __forceinline__ void qkt(f32x16& p0, f32x16& p1, const char* Ks, const bf16x8* qr, int r32, int hi, float init) {
#pragma unroll
    for (int r = 0; r < 16; ++r) { p0[r] = init; p1[r] = init; }
#pragma unroll
    for (int d0 = 0; d0 < DQ / 16; ++d0) { const int cb = (d0 * 16 + hi * 8) * 2;
        const bf16x8 b0 = *reinterpret_cast<const bf16x8*>(Ks + KSWZ(r32, cb));
        const bf16x8 b1 = *reinterpret_cast<const bf16x8*>(Ks + KSWZ(32 + r32, cb));
        p0 = __builtin_amdgcn_mfma_f32_32x32x16_bf16(b0, qr[d0], p0, 0, 0, 0);
        p1 = __builtin_amdgcn_mfma_f32_32x32x16_bf16(b1, qr[d0], p1, 0, 0, 0);
        if (DQ == 128 && d0 == 3) SBAR(); }
}
template <int DV> __device__ __forceinline__ int v_st(int k, int c) { const int kk = (k & ~0xC) | ((k & 4) << 1) | ((k & 8) >> 1); return ((kk >> 3) * (DV / 32) + (c >> 5)) * 512 + ((kk & 7) * 32 + (c & 31)) * 2; }
__device__ __forceinline__ int v_rd_base(int lane) { return ((lane & 3) << 3) | (((lane >> 2) & 3) << 6) | (((lane >> 4) & 1) << 5) | (((lane >> 5) & 1) << 8); }
template <int DV> constexpr int v_rd_off(int d0, int ks, int half) { return d0 * 512 + ks * (4096 * DV / 128) + half * (2048 * DV / 128); }
template <int OFF> __device__ __forceinline__ s16x4 tr_read(int vb) {
    s16x4 r; asm volatile("ds_read_b64_tr_b16 %0, %1 offset:%2" : "=&v"(r) : "v"(vb), "i"(OFF) : "memory"); return r;
}
template <int DV, int D0> __device__ __forceinline__ void pv_one(f32x16& od, int vb, bf16x8 pa0, bf16x8 pa1, bf16x8 pa2, bf16x8 pa3) {
    const s16x4 l0 = tr_read<v_rd_off<DV>(D0, 0, 0)>(vb), h0 = tr_read<v_rd_off<DV>(D0, 0, 1)>(vb), l1 = tr_read<v_rd_off<DV>(D0, 1, 0)>(vb), h1 = tr_read<v_rd_off<DV>(D0, 1, 1)>(vb);
    const s16x4 l2 = tr_read<v_rd_off<DV>(D0, 2, 0)>(vb), h2 = tr_read<v_rd_off<DV>(D0, 2, 1)>(vb), l3 = tr_read<v_rd_off<DV>(D0, 3, 0)>(vb), h3 = tr_read<v_rd_off<DV>(D0, 3, 1)>(vb);
    asm volatile("s_waitcnt lgkmcnt(0)" ::: "memory"); SBAR();
#define PK(L, H) (bf16x8){L[0], L[1], L[2], L[3], H[0], H[1], H[2], H[3]}
    od = __builtin_amdgcn_mfma_f32_32x32x16_bf16(pa0, PK(l0, h0), od, 0, 0, 0);
    od = __builtin_amdgcn_mfma_f32_32x32x16_bf16(pa1, PK(l1, h1), od, 0, 0, 0);
    od = __builtin_amdgcn_mfma_f32_32x32x16_bf16(pa2, PK(l2, h2), od, 0, 0, 0);
    od = __builtin_amdgcn_mfma_f32_32x32x16_bf16(pa3, PK(l3, h3), od, 0, 0, 0);
#undef PK
}
template <int DV> __device__ __forceinline__ void pv_all(f32x16* o, int vb, bf16x8 pa0, bf16x8 pa1, bf16x8 pa2, bf16x8 pa3) {
    pv_one<DV, 0>(o[0], vb, pa0, pa1, pa2, pa3); pv_one<DV, 1>(o[1], vb, pa0, pa1, pa2, pa3);
    if constexpr (DV == 128) { pv_one<DV, 2>(o[2], vb, pa0, pa1, pa2, pa3); pv_one<DV, 3>(o[3], vb, pa0, pa1, pa2, pa3); }
}

template <int DQ, int DV, int SD, int ldq, int ldo, bool PRE, bool FAST>
__device__ __forceinline__ void attn_unit(const bf16_t* Qb, const bf16_t* Kh, const bf16_t* Vh, bf16_t* OG, int seq, char* lds, const int tid, const float* qn, float kmax) {
    constexpr int NQ = DQ / 16, NO = DV / 32, SHM_V = KVBLK * DV * 2;
    constexpr int KCH = DQ / 8, VCH = DV / 8;
    constexpr int NVI = KVBLK * VCH / 512;
    constexpr bool K2ALL = (KVBLK * KCH == 1024);
    const int wid = tid >> 6, lane = tid & 63, r32 = lane & 31, hi = lane >> 5;
    char* V_lds = lds; char* K_lds = lds + 2 * SHM_V;
    float* wsf = (float*)(lds + 2 * SHM_V + 2 * SHM_K) + wid * 64; float* li_l = wsf; float* al_l = wsf + 32;
    float m_reg = -1e30f, l_reg = 0; f32x16 o[NO]; bf16x8 qr[NQ];
    float negm = 0.f; if constexpr (FAST) negm = -(qn[(wid * QBLK + r32) * 8] * kmax);
#pragma unroll
    for (int d = 0; d < NO; ++d) o[d] = f32x16{};
    const bf16_t* Qw = Qb + (size_t)(wid * QBLK + r32) * ldq + hi * 8;
#pragma unroll
    for (int d0 = 0; d0 < NQ; ++d0) qr[d0] = *reinterpret_cast<const bf16x8*>(Qw + d0 * 16);
    const int kc0 = tid, kc1 = tid + 512;
    const int kl0 = KSWZ(kc0 / KCH, (kc0 % KCH) * 16), kl1 = KSWZ(kc1 / KCH, (kc1 % KCH) * 16);
    const bool k1on = K2ALL || (wid < 4);
    const int vl0 = v_st<DV>(tid / VCH, (tid % VCH) * 8), vl1 = v_st<DV>((tid + 512) / VCH, ((tid + 512) % VCH) * 8);
    const int vb0 = (int)(uintptr_t)V_lds + v_rd_base(lane);
    struct Slot { bf16x8 v0, v1, k0, k1; }; Slot sA, sB2; Slot& sB = (SD == 2) ? sB2 : sA;
#define SLOAD(S, key0) do { const bf16_t* kp_ = Kh + (size_t)(key0) * DQ; const bf16_t* vp_ = Vh + (size_t)(key0) * DV; \
        S.v0 = *reinterpret_cast<const bf16x8*>(vp_ + tid * 8); if constexpr (NVI == 2) S.v1 = *reinterpret_cast<const bf16x8*>(vp_ + (tid + 512) * 8); \
        S.k0 = *reinterpret_cast<const bf16x8*>(kp_ + kc0 * 8); if (k1on) S.k1 = *reinterpret_cast<const bf16x8*>(kp_ + kc1 * 8); } while (0)
#define SWRITE(b, S) do { *(bf16x8*)(V_lds + (b) * SHM_V + vl0) = S.v0; if constexpr (NVI == 2) *(bf16x8*)(V_lds + (b) * SHM_V + vl1) = S.v1; \
        *(bf16x8*)(K_lds + (b) * SHM_K + kl0) = S.k0; if (k1on) *(bf16x8*)(K_lds + (b) * SHM_K + kl1) = S.k1; } while (0)
#define RESC(a) do { if (__any((a) < 1.f)) { if (hi == 0) al_l[r32] = (a); asm volatile("s_waitcnt lgkmcnt(0)" ::: "memory"); \
        _Pragma("unroll") for (int d = 0; d < NO; ++d) _Pragma("unroll") for (int r = 0; r < 16; ++r) o[d][r] *= al_l[crow(r, hi)]; } } while (0)
    f32x16 pA0, pA1, pB0, pB1; float mnA, mnB, alA, alB; bf16x8 pa0, pa1, pa2, pa3; const int NT = seq / KVBLK;
    SLOAD(sA, 0); SWRITE(0, sA); __syncthreads();
#define PSM(P0, P1, MN, AL) do { if constexpr (FAST) { fastSM0(P0); AL = 1.f; } else partialSM<DQ, PRE>(P0, P1, m_reg, MN, AL); } while (0)
#define RESCX(a) do { if constexpr (!FAST) RESC(a); } while (0)
    qkt<DQ>(pA0, pA1, K_lds, qr, r32, hi, negm); PSM(pA0, pA1, mnA, alA);
    SLOAD(sB, KVBLK); if (SD == 2 && 2 < NT) SLOAD(sA, 2 * KVBLK);
    SWRITE(1, sB); __syncthreads();
    for (int j = 1; j + 1 < NT; j += 2) {
        SBAR(); qkt<DQ>(pB0, pB1, K_lds + SHM_K, qr, r32, hi, negm);
        finishSM(pA0, pA1, alA, l_reg, pa0, pa1, pa2, pa3); SBAR();
        SLOAD(sB, (j + SD) * KVBLK); SBAR();
        pv_all<DV>(o, vb0, pa0, pa1, pa2, pa3); PSM(pB0, pB1, mnB, alB);
        __syncthreads(); SWRITE(0, sA);
        RESCX(alB); __syncthreads();
        SBAR(); qkt<DQ>(pA0, pA1, K_lds, qr, r32, hi, negm);
        finishSM(pB0, pB1, alB, l_reg, pa0, pa1, pa2, pa3); SBAR();
        if (SD == 1 || j + 3 < NT) SLOAD(sA, (j + 1 + SD) * KVBLK); SBAR();
        pv_all<DV>(o, vb0 + SHM_V, pa0, pa1, pa2, pa3); PSM(pA0, pA1, mnA, alA);
        __syncthreads(); SWRITE(1, sB);
        RESCX(alA); __syncthreads();
    }
    SBAR(); qkt<DQ>(pB0, pB1, K_lds + SHM_K, qr, r32, hi, negm);
    finishSM(pA0, pA1, alA, l_reg, pa0, pa1, pa2, pa3); SBAR();
    pv_all<DV>(o, vb0, pa0, pa1, pa2, pa3); PSM(pB0, pB1, mnB, alB);
    __syncthreads(); RESCX(alB);
    finishSM(pB0, pB1, alB, l_reg, pa0, pa1, pa2, pa3); SBAR();
    pv_all<DV>(o, vb0 + SHM_V, pa0, pa1, pa2, pa3);
#undef PSM
#undef RESCX
    if (hi == 0) li_l[r32] = l_reg; asm volatile("s_waitcnt lgkmcnt(0)" ::: "memory");
    float rli[16];
#pragma unroll
    for (int r = 0; r < 16; ++r) rli[r] = __builtin_amdgcn_rcpf(li_l[crow(r, hi)]);
    bf16_t* Ow = OG + (size_t)(wid * QBLK) * ldo + r32;
    float gte[NO][16];
#pragma unroll
    for (int r = 0; r < 16; ++r)
#pragma unroll
        for (int d0 = 0; d0 < NO; ++d0) gte[d0][r] = siluf_(bf1(Ow[(size_t)crow(r, hi) * ldo + d0 * 32]));
#pragma unroll
    for (int r = 0; r < 16; ++r)
#pragma unroll
        for (int d0 = 0; d0 < NO; ++d0) Ow[(size_t)crow(r, hi) * ldo + d0 * 32] = (bf16_t)(cvtpk(o[d0][r] * rli[r] * gte[d0][r], 0.f) & 0xffffu);
    __syncthreads();
#undef SLOAD
#undef SWRITE
#undef RESC
}

template <int ldq, int ldo>
__device__ __forceinline__ void attn_fast3(const bf16_t* Qb, const bf16_t* Kh, const bf16_t* Vh, bf16_t* OG, int seq, char* lds, const int tid, const float* qn, float kmax) {
    constexpr int DQ = 96, DV = 64, NQ = DQ / 16, NO = DV / 32, SHM_V = KVBLK * DV * 2, KCH = DQ / 8, VCH = DV / 8;
    const int wid = tid >> 6, lane = tid & 63, r32 = lane & 31, hi = lane >> 5;
    char* K_lds = lds; char* V_lds = lds + 3 * SHM_K;
    float* li_l = (float*)(lds + 3 * SHM_K + 3 * SHM_V) + wid * 64;
    float l_reg = 0; f32x16 o[NO]; bf16x8 qr[NQ];
    const float negm = -(qn[(wid * QBLK + r32) * 8] * kmax);
#pragma unroll
    for (int d = 0; d < NO; ++d) o[d] = f32x16{};
    const bf16_t* Qw = Qb + (size_t)(wid * QBLK + r32) * ldq + hi * 8;
#pragma unroll
    for (int d0 = 0; d0 < NQ; ++d0) qr[d0] = *reinterpret_cast<const bf16x8*>(Qw + d0 * 16);
    const int kc0 = tid, kc1 = tid + 512;
    const int kl0 = KSWZ(kc0 / KCH, (kc0 % KCH) * 16), kl1 = KSWZ(kc1 / KCH, (kc1 % KCH) * 16);
    const bool k1on = (wid < 4);
    const int vl0 = v_st<DV>(tid / VCH, (tid % VCH) * 8);
    const int vb0 = (int)(uintptr_t)V_lds + v_rd_base(lane);
    struct Slot { bf16x8 v0, k0, k1; }; Slot sA, sB;
#define SLOAD3(S, key0) do { const bf16_t* kp_ = Kh + (size_t)(key0) * DQ; const bf16_t* vp_ = Vh + (size_t)(key0) * DV; \
        S.v0 = *reinterpret_cast<const bf16x8*>(vp_ + tid * 8); S.k0 = *reinterpret_cast<const bf16x8*>(kp_ + kc0 * 8); if (k1on) S.k1 = *reinterpret_cast<const bf16x8*>(kp_ + kc1 * 8); } while (0)
#define SWRITE3(b, S) do { *(bf16x8*)(V_lds + (b) * SHM_V + vl0) = S.v0; *(bf16x8*)(K_lds + (b) * SHM_K + kl0) = S.k0; if (k1on) *(bf16x8*)(K_lds + (b) * SHM_K + kl1) = S.k1; } while (0)
    f32x16 pA0, pA1, pB0, pB1; bf16x8 pa0, pa1, pa2, pa3; const int NT = seq / KVBLK;
    SLOAD3(sA, 0); SLOAD3(sB, KVBLK); SWRITE3(0, sA); SWRITE3(1, sB); SLOAD3(sA, 2 * KVBLK); __syncthreads();
    qkt<DQ>(pA0, pA1, K_lds, qr, r32, hi, negm); fastSM0(pA0);
#define STEP3(PQ0, PQ1, PF0, PF1, SL, SW, J, BX, BY, BZ, DOLOAD, DOWRITE) do { \
        SBAR(); qkt<DQ>(PQ0, PQ1, K_lds + (BY) * SHM_K, qr, r32, hi, negm); \
        { float al_ = 1.f; finishSM(PF0, PF1, al_, l_reg, pa0, pa1, pa2, pa3); } __builtin_amdgcn_sched_group_barrier(0x100, 12, 0); SBAR(); \
        if (DOLOAD) SLOAD3(SL, ((J) + 3) * KVBLK); SBAR(); \
        pv_all<DV>(o, vb0 + (BX) * SHM_V, pa0, pa1, pa2, pa3); fastSM0(PQ0); \
        if (DOWRITE) SWRITE3(BZ, SW); \
        __syncthreads(); } while (0)
    int j = 0;
    for (; j + 6 < NT - 3; j += 6) {
        STEP3(pB0, pB1, pA0, pA1, sB, sA, j + 0, 0, 1, 2, true, true);
        STEP3(pA0, pA1, pB0, pB1, sA, sB, j + 1, 1, 2, 0, true, true);
        STEP3(pB0, pB1, pA0, pA1, sB, sA, j + 2, 2, 0, 1, true, true);
        STEP3(pA0, pA1, pB0, pB1, sA, sB, j + 3, 0, 1, 2, true, true);
        STEP3(pB0, pB1, pA0, pA1, sB, sA, j + 4, 1, 2, 0, true, true);
        STEP3(pA0, pA1, pB0, pB1, sA, sB, j + 5, 2, 0, 1, true, true);
    }
    STEP3(pB0, pB1, pA0, pA1, sB, sA, j + 0, 0, 1, 2, true, true);
    STEP3(pA0, pA1, pB0, pB1, sA, sB, j + 1, 1, 2, 0, false, true);
    STEP3(pB0, pB1, pA0, pA1, sB, sA, j + 2, 2, 0, 1, false, false);
    SBAR(); { float al_ = 1.f; finishSM(pB0, pB1, al_, l_reg, pa0, pa1, pa2, pa3); } SBAR();
    pv_all<DV>(o, vb0 + 0 * SHM_V, pa0, pa1, pa2, pa3);
#undef STEP3
#undef SLOAD3
#undef SWRITE3
    if (hi == 0) li_l[r32] = l_reg; asm volatile("s_waitcnt lgkmcnt(0)" ::: "memory");
    float rli[16];
#pragma unroll
    for (int r = 0; r < 16; ++r) rli[r] = __builtin_amdgcn_rcpf(li_l[crow(r, hi)]);
    bf16_t* Ow = OG + (size_t)(wid * QBLK) * ldo + r32;
    float gte[NO][16];
#pragma unroll
    for (int r = 0; r < 16; ++r)
#pragma unroll
        for (int d0 = 0; d0 < NO; ++d0) gte[d0][r] = siluf_(bf1(Ow[(size_t)crow(r, hi) * ldo + d0 * 32]));
#pragma unroll
    for (int r = 0; r < 16; ++r)
#pragma unroll
        for (int d0 = 0; d0 < NO; ++d0) Ow[(size_t)crow(r, hi) * ldo + d0 * 32] = (bf16_t)(cvtpk(o[d0][r] * rli[r] * gte[d0][r], 0.f) & 0xffffu);
    __syncthreads();
}

template <int ldq, int ldo>
__device__ __forceinline__ void attn_dma4(const bf16_t* Qb, const bf16_t* Kh, const bf16_t* Vh, bf16_t* OG, int seq, char* lds, const int tid, const float* qn, float kmax) {
    constexpr int DQ = 96, DV = 64, NQ = DQ / 16, NO = DV / 32, SHM_V = KVBLK * DV * 2;
    const int wid = __builtin_amdgcn_readfirstlane(tid >> 6), lane = tid & 63, r32 = lane & 31, hi = lane >> 5;
    char* K_lds = lds; char* V_lds = lds + 4 * SHM_K;
    LAS unsigned char* Kl = (LAS unsigned char*)lds; LAS unsigned char* Vl = Kl + 4 * SHM_K;
    float* li_l = (float*)(lds + 4 * SHM_K + 4 * SHM_V) + wid * 64;
    float l_reg = 0; f32x16 o[NO]; bf16x8 qr[NQ];
    const float negm = -(qn[(wid * QBLK + r32) * 8] * kmax);
#pragma unroll
    for (int d = 0; d < NO; ++d) o[d] = f32x16{};
    const bf16_t* Qw = Qb + (size_t)(wid * QBLK + r32) * ldq + hi * 8;
#pragma unroll
    for (int d0 = 0; d0 < NQ; ++d0) qr[d0] = *reinterpret_cast<const bf16x8*>(Qw + d0 * 16);
    int kofs0, kofs1, vofs;
    { const int rowa = 4 * wid + (lane >> 4), rowb = rowa + 32, slot = lane & 15;
      const int fa = (rowa & 7) | (((rowa >> 4) & 1) << 3), fb = (rowb & 7) | (((rowb >> 4) & 1) << 3);
      const int ca = slot ^ fa, cb = slot ^ fb;
      kofs0 = rowa * DQ + (ca < 12 ? ca * 8 : 0); kofs1 = rowb * DQ + (cb < 12 ? cb * 8 : 0);
      const int sidx = wid * 64 + lane, sub = sidx >> 5, within = sidx & 31, kk = (sub >> 1) * 8 + (within >> 2), cc = (sub & 1) * 32 + (within & 3) * 8;
      const int key = (kk & ~0xC) | ((kk & 4) << 1) | ((kk & 8) >> 1);
      vofs = key * DV + cc; }
    const int vb0 = (int)(uintptr_t)V_lds + v_rd_base(lane);
#define DMA_TILE(T, SLOT) do { const bf16_t* kp_ = Kh + (size_t)(T) * (KVBLK * DQ); const bf16_t* vp_ = Vh + (size_t)(T) * (KVBLK * DV); \
        __builtin_amdgcn_global_load_lds((const unsigned*)(kp_ + kofs0), (LAS unsigned*)(Kl + (SLOT) * SHM_K + wid * 1024), 16, 0, 0); \
        __builtin_amdgcn_global_load_lds((const unsigned*)(kp_ + kofs1), (LAS unsigned*)(Kl + (SLOT) * SHM_K + 8192 + wid * 1024), 16, 0, 0); \
        __builtin_amdgcn_global_load_lds((const unsigned*)(vp_ + vofs), (LAS unsigned*)(Vl + (SLOT) * SHM_V + wid * 1024), 16, 0, 0); } while (0)
#define BAR_DMA(N) do { asm volatile("s_waitcnt vmcnt(" #N ")" ::: "memory"); asm volatile("s_waitcnt lgkmcnt(0)" ::: "memory"); __builtin_amdgcn_s_barrier(); asm volatile("" ::: "memory"); SBAR(); } while (0)
    f32x16 pA0, pA1, pB0, pB1; bf16x8 pa0, pa1, pa2, pa3; const int NT = seq / KVBLK;
    asm volatile("s_waitcnt lgkmcnt(0)" ::: "memory"); __builtin_amdgcn_s_barrier(); asm volatile("" ::: "memory");
    DMA_TILE(0, 0); DMA_TILE(1, 1); DMA_TILE(2, 2);
    BAR_DMA(3);
    qkt<DQ>(pA0, pA1, K_lds, qr, r32, hi, negm); fastSM0(pA0);
#define STEPD(PQ0, PQ1, PF0, PF1, J, S0, DOLOAD) do { \
        SBAR(); qkt<DQ>(PQ0, PQ1, K_lds + (((S0) + 1) & 3) * SHM_K, qr, r32, hi, negm); \
        { float al_ = 1.f; finishSM(PF0, PF1, al_, l_reg, pa0, pa1, pa2, pa3); } __builtin_amdgcn_sched_group_barrier(0x100, 12, 0); SBAR(); \
        if (DOLOAD) DMA_TILE((J) + 3, ((S0) + 3) & 3); SBAR(); \
        pv_all<DV>(o, vb0 + (S0) * SHM_V, pa0, pa1, pa2, pa3); fastSM0(PQ0); \
        if (DOLOAD) BAR_DMA(3); else BAR_DMA(0); } while (0)
    int j = 0;
    for (; j + 4 <= NT - 4; j += 4) {
        STEPD(pB0, pB1, pA0, pA1, j + 0, 0, true); STEPD(pA0, pA1, pB0, pB1, j + 1, 1, true);
        STEPD(pB0, pB1, pA0, pA1, j + 2, 2, true); STEPD(pA0, pA1, pB0, pB1, j + 3, 3, true);
    }
    STEPD(pB0, pB1, pA0, pA1, j + 0, 0, true);
    STEPD(pA0, pA1, pB0, pB1, j + 1, 1, false);
    STEPD(pB0, pB1, pA0, pA1, j + 2, 2, false);
    SBAR(); { float al_ = 1.f; finishSM(pB0, pB1, al_, l_reg, pa0, pa1, pa2, pa3); } SBAR();
    pv_all<DV>(o, vb0 + 3 * SHM_V, pa0, pa1, pa2, pa3);
#undef STEPD
#undef DMA_TILE
#undef BAR_DMA
    if (hi == 0) li_l[r32] = l_reg; asm volatile("s_waitcnt lgkmcnt(0)" ::: "memory");
    float rli[16];
#pragma unroll
    for (int r = 0; r < 16; ++r) rli[r] = __builtin_amdgcn_rcpf(li_l[crow(r, hi)]);
    bf16_t* Ow = OG + (size_t)(wid * QBLK) * ldo + r32;
    float gte[NO][16];
#pragma unroll
    for (int r = 0; r < 16; ++r)
#pragma unroll
        for (int d0 = 0; d0 < NO; ++d0) gte[d0][r] = siluf_(bf1(Ow[(size_t)crow(r, hi) * ldo + d0 * 32]));
#pragma unroll
    for (int r = 0; r < 16; ++r)
#pragma unroll
        for (int d0 = 0; d0 < NO; ++d0) Ow[(size_t)crow(r, hi) * ldo + d0 * 32] = (bf16_t)(cvtpk(o[d0][r] * rli[r] * gte[d0][r], 0.f) & 0xffffu);
    __syncthreads();
}

template <int ldq, int ldo>
__device__ __forceinline__ void attn_mem(const bf16_t* Qb, const bf16_t* Kh, const bf16_t* Vh, bf16_t* OG, char* lds, const int tid) {
    constexpr int DQ = 128, DV = 128, NQ = DQ / 16, NO = DV / 32, SHM_V = KVBLK * DV * 2, NT = 4;
    const int wid = __builtin_amdgcn_readfirstlane(tid >> 6), lane = tid & 63, r32 = lane & 31, hi = lane >> 5;
    char* K_lds = lds; char* V_lds = lds + NT * SHM_K;
    LAS unsigned char* Kl = (LAS unsigned char*)lds; LAS unsigned char* Vl = Kl + NT * SHM_K;
    float* wsf = (float*)(lds + LDS_SCR_OFF) + wid * 64; float* li_l = wsf; float* al_l = wsf + 32;
    int kofs, vofs0, vofs1;
    { const int rowa = 4 * wid + (lane >> 4), slot = lane & 15, fa = (rowa & 7) | (((rowa >> 4) & 1) << 3);
      kofs = rowa * DQ + (slot ^ fa) * 8;
      const int s0 = wid * 64 + lane, s1 = (wid + 8) * 64 + lane;
      { const int sub = s0 >> 5, within = s0 & 31, kk = (sub >> 2) * 8 + (within >> 2), cc = (sub & 3) * 32 + (within & 3) * 8; vofs0 = ((kk & ~0xC) | ((kk & 4) << 1) | ((kk & 8) >> 1)) * DV + cc; }
      { const int sub = s1 >> 5, within = s1 & 31, kk = (sub >> 2) * 8 + (within >> 2), cc = (sub & 3) * 32 + (within & 3) * 8; vofs1 = ((kk & ~0xC) | ((kk & 4) << 1) | ((kk & 8) >> 1)) * DV + cc; } }
    const int vb0 = (int)(uintptr_t)V_lds + v_rd_base(lane);
    asm volatile("s_waitcnt lgkmcnt(0)" ::: "memory"); __builtin_amdgcn_s_barrier(); asm volatile("" ::: "memory");
#pragma unroll
    for (int i = 0; i < 8; ++i)
        __builtin_amdgcn_global_load_lds((const unsigned*)(Kh + kofs + i * 32 * DQ), (LAS unsigned*)(Kl + (wid + 8 * i) * 1024), 16, 0, 0);
#pragma unroll
    for (int t = 0; t < NT; ++t) {
        __builtin_amdgcn_global_load_lds((const unsigned*)(Vh + t * KVBLK * DV + vofs0), (LAS unsigned*)(Vl + t * SHM_V + wid * 1024), 16, 0, 0);
        __builtin_amdgcn_global_load_lds((const unsigned*)(Vh + t * KVBLK * DV + vofs1), (LAS unsigned*)(Vl + t * SHM_V + (wid + 8) * 1024), 16, 0, 0); }
    bf16x8 qr[NQ]; f32x16 o[NO]; float m_reg = -1e30f, l_reg = 0.f;
#pragma unroll
    for (int d = 0; d < NO; ++d) o[d] = f32x16{};
    const bf16_t* Qw = Qb + (size_t)(wid * QBLK + r32) * ldq + hi * 8;
#pragma unroll
    for (int d0 = 0; d0 < NQ; ++d0) qr[d0] = *reinterpret_cast<const bf16x8*>(Qw + d0 * 16);
    asm volatile("s_waitcnt vmcnt(0)" ::: "memory"); asm volatile("s_waitcnt lgkmcnt(0)" ::: "memory"); __builtin_amdgcn_s_barrier(); asm volatile("" ::: "memory"); SBAR();
    f32x16 p0, p1; bf16x8 pa0, pa1, pa2, pa3;
#pragma unroll
    for (int t = 0; t < NT; ++t) {
        float mn, al;
        qkt<DQ>(p0, p1, K_lds + t * SHM_K, qr, r32, hi, 0.f);
        partialSM<DQ, false>(p0, p1, m_reg, mn, al);
        if (__any(al < 1.f)) { if (hi == 0) al_l[r32] = al; asm volatile("s_waitcnt lgkmcnt(0)" ::: "memory");
#pragma unroll
            for (int d = 0; d < NO; ++d)
#pragma unroll
                for (int r = 0; r < 16; ++r) o[d][r] *= al_l[crow(r, hi)]; }
        finishSM(p0, p1, al, l_reg, pa0, pa1, pa2, pa3); SBAR();
        pv_all<DV>(o, vb0 + t * SHM_V, pa0, pa1, pa2, pa3);
    }
    if (hi == 0) li_l[r32] = l_reg; asm volatile("s_waitcnt lgkmcnt(0)" ::: "memory");
    float rli[16];
#pragma unroll
    for (int r = 0; r < 16; ++r) rli[r] = __builtin_amdgcn_rcpf(li_l[crow(r, hi)]);
    bf16_t* Ow = OG + (size_t)(wid * QBLK) * ldo + r32;
#pragma unroll
    for (int dh = 0; dh < 2; ++dh) {
        float gte[2][16];
#pragma unroll
        for (int r = 0; r < 16; ++r)
#pragma unroll
            for (int d0 = 0; d0 < 2; ++d0) gte[d0][r] = siluf_(bf1(Ow[(size_t)crow(r, hi) * ldo + (2 * dh + d0) * 32]));
#pragma unroll
        for (int r = 0; r < 16; ++r)
#pragma unroll
            for (int d0 = 0; d0 < 2; ++d0) Ow[(size_t)crow(r, hi) * ldo + (2 * dh + d0) * 32] = (bf16_t)(cvtpk(o[2 * dh + d0][r] * rli[r] * gte[d0][r], 0.f) & 0xffffu);
        asm volatile("" ::: "memory"); }
    __syncthreads();
}
}

constexpr int NWAVES = 8;
constexpr int LDS_BYTES = 135168, LDS_CTL_OFF = 132096;

struct Params {
    const float* x; const float* mem; const int* pos;
    const float *norm_g, *w_in, *b_gate, *q_norm_g, *w_uq, *kv_norm_g, *w_ukv, *q_head_g, *k_head_g, *conv_w, *conv_b, *mem_norm_g, *w_mkv, *mem_q_g, *mem_k_g,
                *w_br_attn, *w_br_conv, *w_br_mem, *w_out;
    float* out; unsigned char* ws;
    float inv_freq[16];
};

__device__ __forceinline__ void transpose_item(const float* W, int ldn, int K, const float* gain, bf16_t* WT, int k0, int n0src, int dstrow, LAS float* scr, int lane) {
#pragma unroll
    for (int i = 0; i < 8; ++i) { const int kk = 8 * i + (lane >> 3), c4 = (lane & 7) * 4; const float gn = gain ? gain[k0 + kk] : 1.f;
        const f32x4 v = *(const f32x4*)(W + (size_t)(k0 + kk) * ldn + n0src + c4);
        scr[kk * 33 + c4 + 0] = v.x * gn; scr[kk * 33 + c4 + 1] = v.y * gn; scr[kk * 33 + c4 + 2] = v.z * gn; scr[kk * 33 + c4 + 3] = v.w * gn; }
    asm volatile("s_waitcnt lgkmcnt(0)" ::: "memory");
    const int c = lane & 7;
#pragma unroll
    for (int j = 0; j < 4; ++j) { const int n = (lane >> 3) + 8 * j; const LAS float* s = scr + (8 * c) * 33 + n;
        u32x4 o; o.x = cvtpk(s[0 * 33], s[1 * 33]); o.y = cvtpk(s[2 * 33], s[3 * 33]); o.z = cvtpk(s[4 * 33], s[5 * 33]); o.w = cvtpk(s[6 * 33], s[7 * 33]);
        *(u32x4*)(WT + (size_t)(dstrow + n) * K + k0 + 8 * c) = o; }
    asm volatile("s_waitcnt lgkmcnt(0)" ::: "memory");
}
__device__ __forceinline__ int win_dst_col(int n) {
    if (n < 384) return C_QLAT + n;
    if (n < 640) return C_KVLAT + (n - 384);
    if (n < 672) return C_KPE + (n - 640);
    if (n < 1184) return C_CB + (n - 672);
    if (n < 1696) return C_CC + (n - 1184);
    if (n < 2208) return C_CU + (n - 1696);
    if (n < 2720) return C_QMEM + (n - 2208);
    if (n < 3232) return C_GATTN + (n - 2720);
    if (n < 3744) return C_GCONV + (n - 3232);
    if (n < 4256) return C_GMEM + (n - 3744);
    return n - 4256;
}
__device__ __forceinline__ void rows_to_bf16(const float* xin, bf16_t* xb, float* rstd, int rows, int gw, int NGW, int lane) {
    for (int m = gw; m < rows; m += NGW) {
        const f32x4* xr = (const f32x4*)(xin + (size_t)m * 1024) + lane;
        f32x4 v[4]; float s = 0.f;
#pragma unroll
        for (int j = 0; j < 4; ++j) { v[j] = xr[64 * j]; s += (v[j].x * v[j].x + v[j].y * v[j].y) + (v[j].z * v[j].z + v[j].w * v[j].w); }
        s = wave_sum(s);
        if (lane == 0) rstd[m] = rsqrtf(s * (1.f / 1024.f) + EPS);
        u32x2* o8 = (u32x2*)(xb + (size_t)m * 1024) + lane;
#pragma unroll
        for (int j = 0; j < 4; ++j) { u32x2 w; w.x = cvtpk(v[j].x, v[j].y); w.y = cvtpk(v[j].z, v[j].w); o8[64 * j] = w; }
    }
}

#define XB_TMO      128
#define XB_XCNT(j)  (256  + 64 * (j))
#define XB_XSUB(j)  (1280 + 64 * (j))
#define XB_XGEN(j)  (2304 + 64 * (j))
#define XB_TOP      3328
#define XB_TOPGEN   3392
#define XCD_BAR_WORDS 3456
#define XB_SPIN_CAP (1u << 18)
__device__ __forceinline__ unsigned xb_ld(unsigned* p)              { return __hip_atomic_load(p, __ATOMIC_RELAXED, __HIP_MEMORY_SCOPE_AGENT); }
__device__ __forceinline__ unsigned xb_add(unsigned* p, unsigned v) { return __hip_atomic_fetch_add(p, v, __ATOMIC_RELAXED, __HIP_MEMORY_SCOPE_AGENT); }
__device__ __forceinline__ unsigned xb_xcc_id() { return (unsigned)__builtin_amdgcn_s_getreg((3 << 11) | 20) & 0xFu; }
#define XB_SPIN(cond, bar) do { unsigned _sp = 0; while (cond) { __builtin_amdgcn_s_sleep(1); \
    if ((++_sp & 255u) == 0u) { if (xb_ld(&(bar)[XB_TMO])) break; if (_sp > XB_SPIN_CAP) { atomicAdd(&(bar)[XB_TMO], 1u); break; } } } } while (0)
struct XcdBarrier { unsigned* bar; unsigned x; volatile LAS unsigned* st; };
__device__ __forceinline__ XcdBarrier xcd_barrier_post(unsigned* bar, volatile LAS unsigned* st) {
    XcdBarrier b; b.bar = bar; b.x = xb_xcc_id(); b.st = st;
    if (threadIdx.x == 0) (void)xb_add(&bar[XB_XCNT(b.x)], 1u);
    return b;
}
__device__ __forceinline__ void xcd_barrier_complete(unsigned* bar, unsigned x, unsigned& nloc, unsigned& nx) {
    const unsigned G = gridDim.x * gridDim.y * gridDim.z;
    unsigned sum, cnt, mine, sp = 0u;
    for (;;) {
        sum = 0u; cnt = 0u; mine = 0u;
#pragma unroll
        for (unsigned j = 0; j < 16; ++j) { const unsigned c = xb_ld(&bar[XB_XCNT(j)]); sum += c; cnt += (c > 0u) ? 1u : 0u; mine = (j == x) ? c : mine; }
        if (sum == G) break;
        __builtin_amdgcn_s_sleep(1);
        if ((++sp & 255u) == 0u) { if (xb_ld(&bar[XB_TMO])) break; if (sp > XB_SPIN_CAP) { atomicAdd(&bar[XB_TMO], 1u); break; } }
    }
    nloc = mine > 0u ? mine : 1u; nx = cnt > 0u ? cnt : 1u;
}
__device__ __forceinline__ void xcd_barrier(const XcdBarrier& b) {
    asm volatile("s_waitcnt vmcnt(0)" ::: "memory");
    __syncthreads();
    if (threadIdx.x == 0) {
        unsigned* bar = b.bar;
        __builtin_amdgcn_s_waitcnt(0);
        unsigned nloc = b.st[0], nx = b.st[1];
        if (nloc == 0u) { xcd_barrier_complete(bar, b.x, nloc, nx); b.st[0] = nloc; b.st[1] = nx; }
        const unsigned old = xb_add(&bar[XB_XSUB(b.x)], 1u);
        const unsigned gen = old / nloc;
        if (old + 1u == (gen + 1u) * nloc) {
            __builtin_amdgcn_fence(__ATOMIC_RELEASE, "agent");
            asm volatile("s_waitcnt vmcnt(0)" ::: "memory");
            const unsigned og = xb_add(&bar[XB_TOP], 1u);
            const unsigned tg = og / nx;
            if (og + 1u == (tg + 1u) * nx) xb_add(&bar[XB_TOPGEN], 1u);
            else XB_SPIN(xb_ld(&bar[XB_TOPGEN]) == tg, bar);
            __builtin_amdgcn_fence(__ATOMIC_ACQUIRE, "agent");
            xb_add(&bar[XB_XGEN(b.x)], 1u);
            asm volatile("s_waitcnt vmcnt(0)" ::: "memory");
        } else {
            XB_SPIN(xb_ld(&bar[XB_XGEN(b.x)]) == gen, bar);
            __builtin_amdgcn_fence(__ATOMIC_ACQUIRE, "agent");
            asm volatile("s_waitcnt vmcnt(0)" ::: "memory");
        }
    }
    __syncthreads();
}

enum { K_S0 = 0, K_S2, K_ROWS, K_CONV, K_QKV, K_MATT, K_ATT, K_G_MKV, K_G_IN, K_G_UQ, K_G_UKV, K_G_BC, K_G_BM, K_G_BA, K_G_OUT };
constexpr int STEPS_PER = 11, N_STEPS = 3 + DEPTH * NB * STEPS_PER;
__host__ __device__ __forceinline__ int step_kind(int s) {
    return s == 0 ? K_G_IN : s == 1 ? K_G_UQ : s == 2 ? K_G_UKV : s == 3 ? K_CONV : s == 4 ? K_QKV : s == 5 ? K_MATT : s == 6 ? K_G_BC : s == 7 ? K_G_BM : s == 8 ? K_ATT : s == 9 ? K_G_BA : K_G_OUT;
}
__host__ __device__ __forceinline__ bool step_sync(int s) { return (0x729 >> s) & 1; }

__global__ void __launch_bounds__(NWAVES * 64, 2) mega(Params p, int lo, int hi) {
    extern __shared__ __attribute__((aligned(16))) unsigned char lds[];
    cg::grid_group grid = cg::this_grid();
    LAS unsigned char* ldsl = (LAS unsigned char*)lds;
    const int G = gridDim.x, bx = blockIdx.x, NGW = G * NWAVES;
    unsigned char* ws = p.ws;
    bf16_t* WMKV = (bf16_t*)(ws + WS_WMKV); bf16_t* MEMB = (bf16_t*)(ws + WS_MEMB); bf16_t* MKVRAW = (bf16_t*)(ws + WS_MKVRAW);
    bf16_t* MK = (bf16_t*)(ws + WS_MK); bf16_t* MV = (bf16_t*)(ws + WS_MV); float* MRSTD = (float*)(ws + WS_MRSTD); float* RSTD = (float*)(ws + WS_RSTD);
    bf16_t* XB = (bf16_t*)(ws + WS_XB); bf16_t* PROJ = (bf16_t*)(ws + WS_PROJ); bf16_t* QRAW = (bf16_t*)(ws + WS_QRAW); bf16_t* KVRAW = (bf16_t*)(ws + WS_KVRAW);
    float* QN = (float*)(ws + WS_QN); float* KQMAX = (float*)(ws + WS_KQMAX);
    bf16_t* QF = (bf16_t*)(ws + WS_QF); bf16_t* KF = (bf16_t*)(ws + WS_KF); bf16_t* VF = (bf16_t*)(ws + WS_VF);
    if (threadIdx.x < 4) ((volatile LAS unsigned*)(ldsl + LDS_CTL_OFF))[threadIdx.x] = 0u;
    __syncthreads();
    const XcdBarrier xbar = xcd_barrier_post((unsigned*)(ws + WS_BAR), (volatile LAS unsigned*)(ldsl + LDS_CTL_OFF));
    for (int st = lo; st < hi; ++st) {
        int tidv = threadIdx.x; asm volatile("" : "+v"(tidv));
        const int tid = tidv, lane = tid & 63, wave = __builtin_amdgcn_readfirstlane(tid >> 6), gw = bx * NWAVES + wave;
        int kind, l = 0, b = 0; bool sync_after = true;
        if (st < 3) kind = (st == 0) ? K_S0 : (st == 1 ? K_G_MKV : K_S2);
        else { const int r = st - 3, i = r / STEPS_PER, sidx = r % STEPS_PER; l = i >> 1; b = i & 1; kind = step_kind(sidx); sync_after = step_sync(sidx); }
        unsigned char* lw = ws + WS_LW + (size_t)l * LW_SIZE;
        const float* xin = (l == 0 ? p.x : (const float*)p.out) + (size_t)b * SEQ * 1024;
        float* xout = p.out + (size_t)b * SEQ * 1024;

#ifndef NO_GEMM
        if (kind >= K_G_MKV) {
            pg8::Gemm g; pg8::EpiRT E; E.mode = 0; E.O = nullptr; E.ldc = PJ; E.rstd = nullptr; E.bias = nullptr; E.R = nullptr; E.Xin = nullptr; E.Xout = nullptr;
            g.M = SEQ; g.N = 1024; g.K = 512; g.lda = PJ;
            if (kind == K_G_MKV)      { g.A = MEMB; g.Bt = WMKV; g.M = NB * MEML; g.N = DEPTH * 1024; g.K = 1024; g.lda = 1024; E.O = MKVRAW; E.ldc = DEPTH * 1024; E.rstd = MRSTD; }
            else if (kind == K_G_IN)  { g.A = XB; g.Bt = (const bf16_t*)(lw + LW_WIN); g.N = PJ; g.K = 1024; g.lda = 1024; E.mode = 1; E.O = PROJ; E.rstd = RSTD; E.bias = p.b_gate + l * 3072; }
            else if (kind == K_G_UQ)  { g.A = PROJ + C_QLAT; g.Bt = (const bf16_t*)(lw + LW_WUQ); g.N = 768; g.K = 384; E.O = QRAW; E.ldc = 768; }
            else if (kind == K_G_UKV) { g.A = PROJ + C_KVLAT; g.Bt = (const bf16_t*)(lw + LW_WUKV); g.N = 1024; g.K = 256; E.O = KVRAW; E.ldc = 1024; }
            else if (kind == K_G_BC)  { g.A = PROJ + C_CB; g.Bt = (const bf16_t*)(lw + LW_WBC); E.mode = 2; E.O = PROJ + C_RCONV; E.R = PROJ + C_RCONV; }
            else if (kind == K_G_BM)  { g.A = PROJ + C_GMEM; g.Bt = (const bf16_t*)(lw + LW_WBM); E.mode = 3; E.O = PROJ + C_RCONV; E.R = PROJ + C_RMEM; }
            else if (kind == K_G_BA)  { g.A = PROJ + C_GATTN; g.Bt = (const bf16_t*)(lw + LW_WBA); E.mode = 3; E.O = PROJ + C_RCONV; E.R = PROJ + C_RATTN; }
            else                      { g.A = PROJ + C_RCONV; g.Bt = (const bf16_t*)(lw + LW_WOUT); g.K = 1024; E.mode = 4; E.Xin = xin; E.Xout = xout; }
            pg8::StaticOrder S; S.init(g.M, g.N, G, bx);
            pg8::gemm_phase(ldsl, g, S, E, tid);
            if (kind == K_G_BA && (l * 2 + b) + 1 < DEPTH * NB) {
                const int ln = (l * 2 + b + 1) >> 1, bn = (l * 2 + b + 1) & 1;
                const float* xn = (ln == 0 ? p.x : (const float*)p.out) + (size_t)bn * SEQ * 1024;
                __syncthreads();
                rows_to_bf16(xn, XB, RSTD, SEQ, gw, NGW, lane);
                if (bx == 0 && tid < 16) KQMAX[tid] = 0.f;
            }
        }
#endif
#ifndef ONLY_GEMM
        if (kind == K_S0) {
            LAS float* scr = (LAS float*)(ldsl + wave * 16384);
            constexpr int I_IN = 16 * (INW / 32), I_UQ = 6 * 24, I_UKV = 4 * 32, I_MKV = 16 * 32, I_BR = 8 * 32, I_OUT = 16 * 32;
            constexpr int I_L = I_IN + I_UQ + I_UKV + I_MKV + 3 * I_BR + I_OUT;
            for (int it = gw; it < DEPTH * I_L; it += NGW) {
                const int ll = it / I_L; int r = it % I_L;
                unsigned char* lwl = ws + WS_LW + (size_t)ll * LW_SIZE;
                const float* src; const float* gain = nullptr; bf16_t* dst; int ldn, K, kb, nb, drow;
                if (r < I_IN) { const int nblk = INW / 32; kb = r / nblk; nb = r % nblk; src = p.w_in + (size_t)ll * 1024 * INW; ldn = INW; K = 1024; gain = p.norm_g + ll * 1024; dst = (bf16_t*)(lwl + LW_WIN); drow = win_dst_col(32 * nb); }
                else if ((r -= I_IN) < I_UQ) { kb = r / 24; nb = r % 24; src = p.w_uq + (size_t)ll * 384 * 768; ldn = 768; K = 384; gain = p.q_norm_g + ll * 384; dst = (bf16_t*)(lwl + LW_WUQ); drow = 32 * nb; }
                else if ((r -= I_UQ) < I_UKV) { kb = r / 32; nb = r % 32; src = p.w_ukv + (size_t)ll * 256 * 1024; ldn = 1024; K = 256; gain = p.kv_norm_g + ll * 256; dst = (bf16_t*)(lwl + LW_WUKV); drow = 32 * nb; }
                else if ((r -= I_UKV) < I_MKV) { kb = r / 32; nb = r % 32; src = p.w_mkv + (size_t)ll * 1024 * 1024; ldn = 1024; K = 1024; gain = p.mem_norm_g + ll * 1024; dst = WMKV; drow = ll * 1024 + 32 * nb; }
                else if ((r -= I_MKV) < 3 * I_BR) { const int which = r / I_BR, rr = r % I_BR; kb = rr / 32; nb = rr % 32;
                    src = (which == 0 ? p.w_br_attn : (which == 1 ? p.w_br_conv : p.w_br_mem)) + (size_t)ll * 512 * 1024; ldn = 1024; K = 512; dst = (bf16_t*)(lwl + LW_WBA + (size_t)which * SZ_WBR); drow = 32 * nb; }
                else { r -= 3 * I_BR; kb = r / 32; nb = r % 32; src = p.w_out + (size_t)ll * 1024 * 1024; ldn = 1024; K = 1024; dst = (bf16_t*)(lwl + LW_WOUT); drow = 32 * nb; }
                transpose_item(src, ldn, K, gain, dst, 64 * kb, 32 * nb, drow, scr, lane);
            }
            for (int i = bx * 512 + tid; i < DEPTH * 96 * 128; i += G * 512) { const int ll = i / (96 * 128), r = i % (96 * 128);
                *(u32x4*)(ws + WS_LW + (size_t)ll * LW_SIZE + LW_WIN + (size_t)INW * 2048 + (size_t)r * 16) = (u32x4){0u, 0u, 0u, 0u}; }
            rows_to_bf16(p.mem, MEMB, MRSTD, NB * MEML, gw, NGW, lane);
            rows_to_bf16(p.x, XB, RSTD, SEQ, gw, NGW, lane);
            if (bx == 0 && tid < 16) KQMAX[tid] = 0.f;
        } else if (kind == K_S2) {
            for (int it = gw; it < NB * MEML * DEPTH; it += NGW) { const int m = it & 511, ll = it >> 9, bb = m >> 8, jr = m & 255;
                const bf16_t* src = MKVRAW + (size_t)m * 4096 + ll * 1024;
#pragma unroll
                for (int i = 0; i < 2; ++i) { const int c = lane + 64 * i, head = c >> 5, part = (c >> 4) & 1, d0 = (c & 15) * 8;
                    const u32x4 w = *(const u32x4*)(src + c * 8);
                    float ss = sumsq8(w); ss = sum16(ss);
                    const float rs = rsqrtf(ss * (1.f / 128.f) + EPS);
                    const float* gk = p.mem_k_g + ll * 128 + d0;
                    u32x4 o = w;
                    if (part == 0) { o.x = cvtpk(bflo(w.x) * rs * gk[0], bfhi(w.x) * rs * gk[1]); o.y = cvtpk(bflo(w.y) * rs * gk[2], bfhi(w.y) * rs * gk[3]);
                                     o.z = cvtpk(bflo(w.z) * rs * gk[4], bfhi(w.z) * rs * gk[5]); o.w = cvtpk(bflo(w.w) * rs * gk[6], bfhi(w.w) * rs * gk[7]); }
                    const size_t hb = (size_t)((ll * 2 + bb) * 4 + head) * 256 * 128;
                    bf16_t* dst = (part == 0) ? MK + hb + (size_t)jr * 128 + d0 : MV + hb + (size_t)jr * 128 + d0;
                    *(u32x4*)dst = o; }
            }
        } else if (kind == K_ROWS) {
            rows_to_bf16(xin, XB, RSTD, SEQ, gw, NGW, lane);
            if (bx == 0 && tid < 16) KQMAX[tid] = 0.f;
        } else if (kind == K_CONV) {
            const float* cw = p.conv_w + l * 3 * 512; const float* cbv = p.conv_b + l * 512; const float* mqg = p.mem_q_g + l * 128;
            const int c0 = lane * 8;
            const f32x4 w0a = *(const f32x4*)(cw + c0), w0b = *(const f32x4*)(cw + c0 + 4), w1a = *(const f32x4*)(cw + 512 + c0), w1b = *(const f32x4*)(cw + 512 + c0 + 4);
            const f32x4 w2a = *(const f32x4*)(cw + 1024 + c0), w2b = *(const f32x4*)(cw + 1024 + c0 + 4), bia = *(const f32x4*)(cbv + c0), bib = *(const f32x4*)(cbv + c0 + 4);
            const f32x4 gqa = *(const f32x4*)(mqg + (lane & 15) * 8), gqb = *(const f32x4*)(mqg + (lane & 15) * 8 + 4);
            const float W0[8] = {w0a.x, w0a.y, w0a.z, w0a.w, w0b.x, w0b.y, w0b.z, w0b.w}, W1[8] = {w1a.x, w1a.y, w1a.z, w1a.w, w1b.x, w1b.y, w1b.z, w1b.w};
            const float W2[8] = {w2a.x, w2a.y, w2a.z, w2a.w, w2b.x, w2b.y, w2b.z, w2b.w}, BI[8] = {bia.x, bia.y, bia.z, bia.w, bib.x, bib.y, bib.z, bib.w};
            const float gq[8] = {gqa.x, gqa.y, gqa.z, gqa.w, gqb.x, gqb.y, gqb.z, gqb.w};
            for (int t = gw; t < SEQ; t += NGW) {
                bf16_t* pr = PROJ + (size_t)t * PJ;
                const u32x4 z4 = (u32x4){0u, 0u, 0u, 0u};
                const u32x4 cc0 = *(const u32x4*)(pr + C_CC + c0), cu0 = *(const u32x4*)(pr + C_CU + c0);
                const u32x4 ccm = t > 0 ? *(const u32x4*)(pr - PJ + C_CC + c0) : z4, cum = t > 0 ? *(const u32x4*)(pr - PJ + C_CU + c0) : z4;
                const u32x4 ccp = t < SEQ - 1 ? *(const u32x4*)(pr + PJ + C_CC + c0) : z4, cup = t < SEQ - 1 ? *(const u32x4*)(pr + PJ + C_CU + c0) : z4;
                const u32x4 cb = *(const u32x4*)(pr + C_CB + c0), gc = *(const u32x4*)(pr + C_GCONV + c0);
                const u32x4 qm = *(const u32x4*)(pr + C_QMEM + c0);
                u32x4 oc;
#pragma unroll
                for (int i = 0; i < 4; ++i) {
                    const float lo_ = bflo(cb[i]) * (W0[2 * i] * bflo(ccm[i]) * bflo(cum[i]) + W1[2 * i] * bflo(cc0[i]) * bflo(cu0[i]) + W2[2 * i] * bflo(ccp[i]) * bflo(cup[i]) + BI[2 * i]) * siluf_(bflo(gc[i]));
                    const float hi_ = bfhi(cb[i]) * (W0[2 * i + 1] * bfhi(ccm[i]) * bfhi(cum[i]) + W1[2 * i + 1] * bfhi(cc0[i]) * bfhi(cu0[i]) + W2[2 * i + 1] * bfhi(ccp[i]) * bfhi(cup[i]) + BI[2 * i + 1]) * siluf_(bfhi(gc[i]));
                    oc[i] = cvtpk(lo_, hi_);
                }
                *(u32x4*)(pr + C_CB + c0) = oc;
                float ss = sumsq8(qm); ss = sum16(ss);
                const float rs = rsqrtf(ss * (1.f / 128.f) + EPS);
                u32x4 oq; oq.x = cvtpk(bflo(qm.x) * rs * gq[0], bfhi(qm.x) * rs * gq[1]); oq.y = cvtpk(bflo(qm.y) * rs * gq[2], bfhi(qm.y) * rs * gq[3]);
                oq.z = cvtpk(bflo(qm.z) * rs * gq[4], bfhi(qm.z) * rs * gq[5]); oq.w = cvtpk(bflo(qm.w) * rs * gq[6], bfhi(qm.w) * rs * gq[7]);
                *(u32x4*)(pr + C_QMEM + c0) = oq;
            }
        } else if (kind == K_QKV) {
            const float* qg = p.q_head_g + l * 96; const float* kg = p.k_head_g + l * 96;
            const int h = lane >> 3, j = lane & 7;
            const float if0 = p.inv_freq[2 * j], if1 = p.inv_freq[2 * j + 1];
            const f32x4 qga = *(const f32x4*)(qg + 8 * j), qgb = *(const f32x4*)(qg + 8 * j + 4), kga = *(const f32x4*)(kg + 8 * j), kgb = *(const f32x4*)(kg + 8 * j + 4);
            const float QG[8] = {qga.x, qga.y, qga.z, qga.w, qgb.x, qgb.y, qgb.z, qgb.w}, KG[8] = {kga.x, kga.y, kga.z, kga.w, kgb.x, kgb.y, kgb.z, kgb.w};
            const float qr0 = qg[64 + 2 * j], qr1 = qg[65 + 2 * j], qr2 = qg[80 + 2 * j], qr3 = qg[81 + 2 * j];
            const float kr0 = kg[64 + 2 * j], kr1 = kg[65 + 2 * j], kr2 = kg[80 + 2 * j], kr3 = kg[81 + 2 * j];
            constexpr float CQ = 0.10206207261596575f * 1.4426950408889634f;
            float qmax2 = 0.f, kmax2 = 0.f;
            for (int t = gw; t < SEQ; t += NGW) {
                const bf16_t* pr = PROJ + (size_t)t * PJ;
                float sq = 0.f, skv = 0.f;
                if (lane < 48) sq = sumsq8(*(const u32x4*)(pr + C_QLAT + lane * 8));
                if (lane < 32) skv = sumsq8(*(const u32x4*)(pr + C_KVLAT + lane * 8));
                sq = wave_sum(sq); skv = wave_sum(skv);
                const float rq = rsqrtf(sq * (1.f / 384.f) + EPS), rkv = rsqrtf(skv * (1.f / 256.f) + EPS);
                const float pf = (float)p.pos[b * SEQ + t];
                const float a0 = pf * if0, a1 = pf * if1;
                const double r0 = (double)a0 * 0.15915494309189535, r1 = (double)a1 * 0.15915494309189535;
                const float f0 = (float)(r0 - rint(r0)), f1 = (float)(r1 - rint(r1));
                const float c0 = __builtin_amdgcn_cosf(f0), s0 = __builtin_amdgcn_sinf(f0), c1 = __builtin_amdgcn_cosf(f1), s1 = __builtin_amdgcn_sinf(f1);
                {
                    const bf16_t* qp = QRAW + (size_t)t * 768 + h * 96;
                    const u32x4 qn = *(const u32x4*)(qp + 8 * j); const unsigned qa = *(const unsigned*)(qp + 64 + 2 * j), qb = *(const unsigned*)(qp + 80 + 2 * j);
                    float v0 = bflo(qn.x) * rq, v1 = bfhi(qn.x) * rq, v2 = bflo(qn.y) * rq, v3 = bfhi(qn.y) * rq, v4 = bflo(qn.z) * rq, v5 = bfhi(qn.z) * rq, v6 = bflo(qn.w) * rq, v7 = bfhi(qn.w) * rq;
                    float t10 = bflo(qa) * rq, t11 = bfhi(qa) * rq, t20 = bflo(qb) * rq, t21 = bfhi(qb) * rq;
                    float ss = (v0 * v0 + v1 * v1) + (v2 * v2 + v3 * v3) + (v4 * v4 + v5 * v5) + (v6 * v6 + v7 * v7) + (t10 * t10 + t11 * t11) + (t20 * t20 + t21 * t21);
                    ss = sum8(ss);
                    const float rh = rsqrtf(ss * (1.f / 96.f) + EPS);
                    const float rc = rh * CQ;
                    v0 *= rc * QG[0]; v1 *= rc * QG[1]; v2 *= rc * QG[2]; v3 *= rc * QG[3]; v4 *= rc * QG[4]; v5 *= rc * QG[5]; v6 *= rc * QG[6]; v7 *= rc * QG[7];
                    t10 *= rc * qr0; t11 *= rc * qr1; t20 *= rc * qr2; t21 *= rc * qr3;
                    float n2 = (v0 * v0 + v1 * v1) + (v2 * v2 + v3 * v3) + (v4 * v4 + v5 * v5) + (v6 * v6 + v7 * v7) + (t10 * t10 + t11 * t11) + (t20 * t20 + t21 * t21);
                    n2 = sum8(n2);
                    qmax2 = fmaxf(qmax2, n2); if (j == 0) QN[(size_t)t * 8 + h] = sqrtf(n2);
                    u32x4 o; o.x = cvtpk(v0, v1); o.y = cvtpk(v2, v3); o.z = cvtpk(v4, v5); o.w = cvtpk(v6, v7);
                    bf16_t* qo = QF + (size_t)t * 768 + h * 96;
                    *(u32x4*)(qo + 8 * j) = o;
                    *(unsigned*)(qo + 64 + 2 * j) = cvtpk(t10 * c0 - t20 * s0, t11 * c1 - t21 * s1);
                    *(unsigned*)(qo + 80 + 2 * j) = cvtpk(t20 * c0 + t10 * s0, t21 * c1 + t11 * s1);
                }
                {
                    const bf16_t* kp = KVRAW + (size_t)t * 1024 + h * 128;
                    const u32x4 kn = *(const u32x4*)(kp + 8 * j), vv = *(const u32x4*)(kp + 64 + 8 * j);
                    const unsigned ka = *(const unsigned*)(pr + C_KPE + 2 * j), kb = *(const unsigned*)(pr + C_KPE + 16 + 2 * j);
                    float v0 = bflo(kn.x) * rkv, v1 = bfhi(kn.x) * rkv, v2 = bflo(kn.y) * rkv, v3 = bfhi(kn.y) * rkv, v4 = bflo(kn.z) * rkv, v5 = bfhi(kn.z) * rkv, v6 = bflo(kn.w) * rkv, v7 = bfhi(kn.w) * rkv;
                    float t10 = bflo(ka), t11 = bfhi(ka), t20 = bflo(kb), t21 = bfhi(kb);
                    float ss = (v0 * v0 + v1 * v1) + (v2 * v2 + v3 * v3) + (v4 * v4 + v5 * v5) + (v6 * v6 + v7 * v7) + (t10 * t10 + t11 * t11) + (t20 * t20 + t21 * t21);
                    ss = sum8(ss);
                    const float rh = rsqrtf(ss * (1.f / 96.f) + EPS);
                    v0 *= rh * KG[0]; v1 *= rh * KG[1]; v2 *= rh * KG[2]; v3 *= rh * KG[3]; v4 *= rh * KG[4]; v5 *= rh * KG[5]; v6 *= rh * KG[6]; v7 *= rh * KG[7];
                    t10 *= rh * kr0; t11 *= rh * kr1; t20 *= rh * kr2; t21 *= rh * kr3;
                    float n2 = (v0 * v0 + v1 * v1) + (v2 * v2 + v3 * v3) + (v4 * v4 + v5 * v5) + (v6 * v6 + v7 * v7) + (t10 * t10 + t11 * t11) + (t20 * t20 + t21 * t21);
                    n2 = sum8(n2);
                    kmax2 = fmaxf(kmax2, n2);
                    u32x4 o; o.x = cvtpk(v0, v1); o.y = cvtpk(v2, v3); o.z = cvtpk(v4, v5); o.w = cvtpk(v6, v7);
                    bf16_t* ko = KF + ((size_t)h * SEQ + t) * 96;
                    *(u32x4*)(ko + 8 * j) = o;
                    *(unsigned*)(ko + 64 + 2 * j) = cvtpk(t10 * c0 - t20 * s0, t11 * c1 - t21 * s1);
                    *(unsigned*)(ko + 80 + 2 * j) = cvtpk(t20 * c0 + t10 * s0, t21 * c1 + t11 * s1);
                    u32x4 ov; ov.x = cvtpk(bflo(vv.x) * rkv, bfhi(vv.x) * rkv); ov.y = cvtpk(bflo(vv.y) * rkv, bfhi(vv.y) * rkv); ov.z = cvtpk(bflo(vv.z) * rkv, bfhi(vv.z) * rkv); ov.w = cvtpk(bflo(vv.w) * rkv, bfhi(vv.w) * rkv);
                    *(u32x4*)(VF + ((size_t)h * SEQ + t) * 64 + 8 * j) = ov;
                }
            }
            {
                LAS float* red = (LAS float*)ldsl;
                if (j == 0) { red[wave * 16 + h] = qmax2; red[wave * 16 + 8 + h] = kmax2; }
                __syncthreads();
                if (tid < 16) { float mx = 0.f;
#pragma unroll
                    for (int w = 0; w < NWAVES; ++w) mx = fmaxf(mx, red[w * 16 + tid]);
                    atomicMax((unsigned*)KQMAX + tid, __float_as_uint(mx)); }
            }
        } else if (kind == K_MATT) {
#ifndef NO_MATT
            for (int u = bx; u < 4 * (SEQ / 256); u += G) { const int hm = u & 3, qb = u >> 2;
                const size_t kvoff = ((size_t)((l * 2 + b) * 4 + hm) * 256) * 128;
                att::attn_mem<PJ, PJ>(PROJ + (size_t)qb * 256 * PJ + C_QMEM + hm * 128, MK + kvoff, MV + kvoff, PROJ + (size_t)qb * 256 * PJ + C_GMEM + hm * 128, (char*)lds, tid);
            }
#endif
        } else if (kind == K_ATT) {
#ifndef NO_ATT
            { int tf = tid; asm volatile("" : "+v"(tf));
              for (int u = bx; u < NH * (SEQ / 256); u += G) { const int hh = u & 7, qb = u >> 3;
                const float kmx = sqrtf(KQMAX[8 + hh]), qmx = sqrtf(KQMAX[hh]);
                if (qmx * kmx <= 60.f)
                    att::attn_dma4<768, PJ>(QF + (size_t)qb * 256 * 768 + hh * 96, KF + (size_t)hh * SEQ * 96, VF + (size_t)hh * SEQ * 64,
                                       PROJ + (size_t)qb * 256 * PJ + C_GATTN + hh * 64, SEQ, (char*)lds, tf, QN + (size_t)qb * 256 * 8 + hh, kmx);
              } }
            { int ts = tid; asm volatile("" : "+v"(ts));
              for (int u = bx; u < NH * (SEQ / 256); u += G) { const int hh = u & 7, qb = u >> 3;
                const float kmx = sqrtf(KQMAX[8 + hh]), qmx = sqrtf(KQMAX[hh]);
                if (!(qmx * kmx <= 60.f))
                    att::attn_unit<96, 64, 1, 768, PJ, true, false>(QF + (size_t)qb * 256 * 768 + hh * 96, KF + (size_t)hh * SEQ * 96, VF + (size_t)hh * SEQ * 64,
                                       PROJ + (size_t)qb * 256 * PJ + C_GATTN + hh * 64, SEQ, (char*)lds, ts, nullptr, 0.f);
              } }
#endif
        }
#endif
        __syncthreads();
        if (sync_after && st + 1 < hi) { if (lo < 0) grid.sync(); else xcd_barrier(xbar); }
    }
}

extern "C" void kernel_launch(void* const* d_in, const int* in_sizes, int n_in, void* d_out, int out_size, void* d_ws, size_t ws_size, hipStream_t stream) {
    static int grid = 0;
    if (grid == 0) {
        if (n_in != 22 || in_sizes[0] != NB * SEQ * DM || out_size != NB * SEQ * DM || ws_size < WS_END) {
            fprintf(stderr, "kernel_launch: shape/workspace mismatch: n_in %d in0 %d out %d ws %zu (need %zu)\n", n_in, n_in > 0 ? in_sizes[0] : -1, out_size, ws_size, (size_t)WS_END); grid = -1; return; }
        int dev = 0, cus = 0, per_cu = 0;
        if (hipGetDevice(&dev) != hipSuccess || hipDeviceGetAttribute(&cus, hipDeviceAttributeMultiprocessorCount, dev) != hipSuccess) { grid = -1; return; }
        if (hipFuncSetAttribute((const void*)mega, hipFuncAttributeMaxDynamicSharedMemorySize, LDS_BYTES) != hipSuccess) { fprintf(stderr, "kernel_launch: hipFuncSetAttribute failed\n"); grid = -1; return; }
        if (hipOccupancyMaxActiveBlocksPerMultiprocessor(&per_cu, (const void*)mega, NWAVES * 64, LDS_BYTES) != hipSuccess || per_cu < 1) { fprintf(stderr, "kernel_launch: occupancy query gave %d\n", per_cu); per_cu = 1; }
        (void)hipGetLastError();
        grid = cus * 1;
    }
    if (grid < 0) return;
    Params p{};
    p.x = (const float*)d_in[0]; p.mem = (const float*)d_in[1]; p.pos = (const int*)d_in[2];
    p.norm_g = (const float*)d_in[3]; p.w_in = (const float*)d_in[4]; p.b_gate = (const float*)d_in[5]; p.q_norm_g = (const float*)d_in[6]; p.w_uq = (const float*)d_in[7];
    p.kv_norm_g = (const float*)d_in[8]; p.w_ukv = (const float*)d_in[9]; p.q_head_g = (const float*)d_in[10]; p.k_head_g = (const float*)d_in[11]; p.conv_w = (const float*)d_in[12];
    p.conv_b = (const float*)d_in[13]; p.mem_norm_g = (const float*)d_in[14]; p.w_mkv = (const float*)d_in[15]; p.mem_q_g = (const float*)d_in[16]; p.mem_k_g = (const float*)d_in[17];
    p.w_br_attn = (const float*)d_in[18]; p.w_br_conv = (const float*)d_in[19]; p.w_br_mem = (const float*)d_in[20]; p.w_out = (const float*)d_in[21];
    p.out = (float*)d_out; p.ws = (unsigned char*)d_ws;
    for (int i = 0; i < 16; ++i) p.inv_freq[i] = (float)pow(10000.0, -(double)i / 16.0);
    if (hipMemsetAsync((char*)d_ws + WS_BAR, 0, 16384, stream) != hipSuccess) { fprintf(stderr, "kernel_launch: memset failed\n"); return; }
#if MK_MULTI
    for (int st = 0; st < N_STEPS;) { int e = st;
        for (;;) { const bool sy = (e < 3) ? true : step_sync((e - 3) % STEPS_PER); ++e; if (sy || e >= N_STEPS) break; }
        hipLaunchKernelGGL(mega, dim3(grid), dim3(NWAVES * 64), LDS_BYTES, stream, p, st, e); st = e; }
#else
    int lo = 0, hi = N_STEPS;
    void* args[] = {&p, &lo, &hi};
    const hipError_t e = hipLaunchCooperativeKernel((const void*)mega, dim3(grid), dim3(NWAVES * 64), args, LDS_BYTES, stream);
    if (e != hipSuccess) fprintf(stderr, "kernel_launch: cooperative launch failed: %s (grid %d)\n", hipGetErrorString(e), grid);
#endif
}
```

```cpp
#include <hip/hip_runtime.h>
#include <hip/hip_cooperative_groups.h>
#include <cstdio>
#include <cstdint>
#include <cmath>
namespace cg = cooperative_groups;

#ifndef EN_MASK
#define EN_MASK 0xFFFF
#endif
#define EN(i) ((EN_MASK >> (i)) & 1)
#ifndef MK_MULTI
#define MK_MULTI 0
#endif

constexpr int DM = 1024, NB = 2, SEQ = 16384, DEPTH = 4, MEML = 256;
constexpr int NH = 8, QLR = 384, KVLR = 256;
constexpr int INW = 7328, PJ = 7424;
constexpr float EPS = 1e-6f;
constexpr int LDS_SCR_OFF = 132224;
constexpr int C_RATTN = 0, C_RCONV = 1024, C_RMEM = 2048, C_GATTN = 3072, C_GCONV = 3584, C_GMEM = 4096, C_CB = 4608, C_CC = 5120, C_CU = 5632,
              C_QMEM = 6144, C_KVLAT = 6656, C_QLAT = 6912, C_KPE = 7296;
constexpr size_t MiB = 1u << 20;
constexpr size_t SZ_WIN = (size_t)PJ * 1024 * 2, SZ_WUQ = 768 * 384 * 2, SZ_WUKV = 1024 * 256 * 2, SZ_WBR = 1024 * 512 * 2, SZ_WOUT = 1024 * 1024 * 2;
constexpr size_t LW_WIN = 0, LW_WUQ = LW_WIN + SZ_WIN, LW_WUKV = LW_WUQ + SZ_WUQ, LW_WBA = LW_WUKV + SZ_WUKV, LW_WBC = LW_WBA + SZ_WBR, LW_WBM = LW_WBC + SZ_WBR,
                 LW_WOUT = LW_WBM + SZ_WBR, LW_SIZE = LW_WOUT + SZ_WOUT;
constexpr size_t WS_LW = 0;
constexpr size_t WS_WMKV = ((WS_LW + 4 * LW_SIZE + 4095) / 4096) * 4096;
constexpr size_t WS_MEMB = WS_WMKV + 8 * MiB;
constexpr size_t WS_MKVRAW = WS_MEMB + 1 * MiB;
constexpr size_t WS_MK = WS_MKVRAW + 4 * MiB;
constexpr size_t WS_MV = WS_MK + 2 * MiB;
constexpr size_t WS_MRSTD = WS_MV + 2 * MiB;
constexpr size_t WS_RSTD = WS_MRSTD + 4096;
constexpr size_t WS_XB = WS_RSTD + 65536;
constexpr size_t WS_PROJ = WS_XB + 32 * MiB;
constexpr size_t WS_QRAW = WS_PROJ + (size_t)SEQ * PJ * 2;
constexpr size_t WS_KVRAW = WS_QRAW + 24 * MiB;
constexpr size_t WS_QF = WS_KVRAW + 32 * MiB;
constexpr size_t WS_KF = WS_QF + 24 * MiB;
constexpr size_t WS_VF = WS_KF + 24 * MiB;
constexpr size_t WS_BAR = WS_VF + 16 * MiB;
constexpr size_t WS_QN = WS_BAR + 16384;
constexpr size_t WS_KQMAX = WS_QN + (size_t)SEQ * 8 * 4;
constexpr size_t WS_END = WS_KQMAX + 256;

typedef unsigned short bf16_t;
typedef short bf16x8 __attribute__((ext_vector_type(8)));
typedef short s16x4 __attribute__((ext_vector_type(4)));
typedef float f32x4 __attribute__((ext_vector_type(4)));
typedef float f32x16 __attribute__((ext_vector_type(16)));
typedef unsigned u32x4 __attribute__((ext_vector_type(4)));
typedef unsigned u32x2 __attribute__((ext_vector_type(2)));
#define LAS __attribute__((address_space(3)))

__device__ __forceinline__ unsigned cvtpk(float lo, float hi) { unsigned r; asm volatile("v_cvt_pk_bf16_f32 %0, %1, %2" : "=v"(r) : "v"(lo), "v"(hi)); return r; }
__device__ __forceinline__ float bflo(unsigned w) { return __uint_as_float(w << 16); }
__device__ __forceinline__ float bfhi(unsigned w) { return __uint_as_float(w & 0xffff0000u); }
__device__ __forceinline__ float bf1(bf16_t h) { return __uint_as_float(((unsigned)h) << 16); }
__device__ __forceinline__ float sigmoidf_(float v) { return __builtin_amdgcn_rcpf(1.f + __builtin_amdgcn_exp2f(-1.4426950408889634f * v)); }
template <int CTRL> __device__ __forceinline__ float dpp_mov(float v) { return __uint_as_float((unsigned)__builtin_amdgcn_update_dpp(0, (int)__float_as_uint(v), CTRL, 0xF, 0xF, true)); }
__device__ __forceinline__ float sum8(float v) { v += dpp_mov<0xB1>(v); v += dpp_mov<0x4E>(v); v += dpp_mov<0x141>(v); return v; }
__device__ __forceinline__ float sum16(float v) { v = sum8(v); v += dpp_mov<0x140>(v); return v; }
__device__ __forceinline__ float wave_sum(float v) {
    v = sum16(v);
    const float a = __uint_as_float((unsigned)__builtin_amdgcn_readlane((int)__float_as_uint(v), 0)), b = __uint_as_float((unsigned)__builtin_amdgcn_readlane((int)__float_as_uint(v), 16));
    const float c = __uint_as_float((unsigned)__builtin_amdgcn_readlane((int)__float_as_uint(v), 32)), d = __uint_as_float((unsigned)__builtin_amdgcn_readlane((int)__float_as_uint(v), 48));
    return (a + b) + (c + d);
}
__device__ __forceinline__ float sumsq8(u32x4 w) {
    float s = 0.f;
#pragma unroll
    for (int i = 0; i < 4; ++i) { const float a = bflo(w[i]), b = bfhi(w[i]); s += a * a + b * b; }
    return s;
}

namespace pg8 {
constexpr int BM = 256, BK = 64, HALF = 128, HTB = HALF * BK * 2, STAGE_BYTES = 8 * HTB, NXCD = 8, WGM = 4;
__host__ __device__ __forceinline__ int lds_byte(int r, int c) { const int st = (r >> 4) * 2 + (c >> 5), rr = r & 15, cc = c & 31, ob = rr * 64 + cc * 2; return st * 1024 + (ob ^ (((ob >> 9) & 1) << 5)); }
__host__ __device__ __forceinline__ void stage_rc(int b, int& R, int& C) { const int st = b / 1024, sb = b % 1024, swz = sb ^ (((sb >> 9) & 1) << 5); R = (st >> 1) * 16 + swz / 64; C = (st & 1) * 32 + (swz % 64) / 2; }
__host__ __device__ __forceinline__ int perm32(int rho) { const int n = rho >> 4, i = rho & 15; return 8 * (i >> 2) + 4 * n + (i & 3); }
struct Unit { int pm, pn; };
struct Gemm { const bf16_t* A; const bf16_t* Bt; int M, N, K, lda; };
struct StaticOrder {
    int nM, nN, nwg, G, c;
    __device__ void init(int M, int N, int G_, int c_) { nM = M / BM; nN = N / BM; nwg = nM * nN; G = G_; c = c_; }
    __device__ bool next(int i, Unit& u) const {
        const long L = (long)i * G + c; if (L >= nwg) return false;
        int wgid = (int)L; { const int q = nwg / NXCD, r = nwg % NXCD, xcd = wgid % NXCD, off = wgid / NXCD; wgid = (xcd < r ? xcd * (q + 1) : r * (q + 1) + (xcd - r) * q) + off; }
        const int nig = WGM * nN, gid = wgid / nig, fm = gid * WGM, gsz = (nM - fm) < WGM ? (nM - fm) : WGM;
        u.pm = fm + ((wgid % nig) % gsz); u.pn = (wgid % nig) / gsz; return true;
    }
};
struct EpiRT {
    static constexpr bool PERM = true;
    int mode; bf16_t* O; int ldc; const float* rstd; const float* bias; const bf16_t* R; const float* Xin; float* Xout; int ldr;
    __device__ __forceinline__ void operator()(const f32x4 (&acc)[2][2][4][2], const Unit& u, int wr, int wc, int fr, int fq) const {
        const int row0 = u.pm * BM + wr * 64 + fr, col0 = u.pn * BM + wc * 32 + 8 * fq;
        const int kind = (mode == 1) ? (u.pn < 12 ? 0 : (u.pn < 18 ? 1 : 2)) : 2;
        f32x4 bv[2][2];
#pragma unroll
        for (int bj = 0; bj < 2; ++bj) { bv[bj][0] = (f32x4){0.f, 0.f, 0.f, 0.f}; bv[bj][1] = bv[bj][0];
            if (kind == 0) { bv[bj][0] = *(const f32x4*)(bias + col0 + bj * HALF); bv[bj][1] = *(const f32x4*)(bias + col0 + bj * HALF + 4); } }
#pragma unroll
        for (int ai = 0; ai < 2; ++ai)
#pragma unroll
            for (int mp = 0; mp < 2; ++mp) {
                float rs[2]; u32x4 t0[2][2], t1[2][2];
#pragma unroll
                for (int mm = 0; mm < 2; ++mm) { const int row = row0 + ai * HALF + (2 * mp + mm) * 16;
                    rs[mm] = rstd ? rstd[row] : 1.f;
#pragma unroll
                    for (int bj = 0; bj < 2; ++bj) {
                        if (mode == 4) { const size_t off = (size_t)row * 1024 + col0 + bj * HALF; t0[mm][bj] = *(const u32x4*)(Xin + off); t1[mm][bj] = *(const u32x4*)(Xin + off + 4); }
                        else if (mode >= 2) { t0[mm][bj] = *(const u32x4*)(R + (size_t)row * ldr + col0 + bj * HALF);
                            if (mode == 3) t1[mm][bj] = *(const u32x4*)(O + (size_t)row * ldc + col0 + bj * HALF); } } }
#pragma unroll
                for (int mm = 0; mm < 2; ++mm) { const int m = 2 * mp + mm; const int row = row0 + ai * HALF + m * 16;
#pragma unroll
                    for (int bj = 0; bj < 2; ++bj) {
                        f32x4 v0 = acc[ai][bj][m][0], v1 = acc[ai][bj][m][1];
                        if (mode == 4) {
                            const size_t off = (size_t)row * 1024 + col0 + bj * HALF;
                            const u32x4 qa = t0[mm][bj], qb = t1[mm][bj];
                            *(f32x4*)(Xout + off) = (f32x4){__uint_as_float(qa.x), __uint_as_float(qa.y), __uint_as_float(qa.z), __uint_as_float(qa.w)} + v0;
                            *(f32x4*)(Xout + off + 4) = (f32x4){__uint_as_float(qb.x), __uint_as_float(qb.y), __uint_as_float(qb.z), __uint_as_float(qb.w)} + v1;
                        } else {
                            v0 = v0 * rs[mm]; v1 = v1 * rs[mm];
                            if (kind == 0) {
                                v0 = v0 + bv[bj][0]; v1 = v1 + bv[bj][1];
#pragma unroll
                                for (int e = 0; e < 4; ++e) { v0[e] = sigmoidf_(v0[e]); v1[e] = sigmoidf_(v1[e]); }
                            } else if (kind == 1) {
#pragma unroll
                                for (int e = 0; e < 4; ++e) { v0[e] = v0[e] * sigmoidf_(v0[e]); v1[e] = v1[e] * sigmoidf_(v1[e]); }
                            }
                            bf16_t* op = O + (size_t)row * ldc + col0 + bj * HALF;
                            if (mode == 2 || mode == 3) { const u32x4 q = t0[mm][bj];
                                v0[0] *= bflo(q[0]); v0[1] *= bfhi(q[0]); v0[2] *= bflo(q[1]); v0[3] *= bfhi(q[1]);
                                v1[0] *= bflo(q[2]); v1[1] *= bfhi(q[2]); v1[2] *= bflo(q[3]); v1[3] *= bfhi(q[3]);
                                if (mode == 3) { const u32x4 y = t1[mm][bj];
                                    v0[0] += bflo(y[0]); v0[1] += bfhi(y[0]); v0[2] += bflo(y[1]); v0[3] += bfhi(y[1]);
                                    v1[0] += bflo(y[2]); v1[1] += bfhi(y[2]); v1[2] += bflo(y[3]); v1[3] += bfhi(y[3]); } }
                            u32x4 w; w.x = cvtpk(v0[0], v0[1]); w.y = cvtpk(v0[2], v0[3]); w.z = cvtpk(v1[0], v1[1]); w.w = cvtpk(v1[2], v1[3]);
                            *(u32x4*)op = w;
                        }
                    } }
                asm volatile("" ::: "memory");
            }
    }
};

template <class EpiT>
__device__ __forceinline__ void gemm_phase(LAS unsigned char* lds, const Gemm g, const StaticOrder& S, const EpiT& E, const int tid) {
    const int wid = __builtin_amdgcn_readfirstlane(tid >> 6), lane = tid & 63, wr = wid >> 2, wc = wid & 3, fr = lane & 15, fq = lane >> 4;
    const int K = g.K, nt = K / BK;
    unsigned voffA[2], voffB[2];
#pragma unroll
    for (int i = 0; i < 2; ++i) { int R, C; stage_rc(tid * 16 + i * 8192, R, C); const int Rb = EpiT::PERM ? ((R & ~31) + perm32(R & 31)) : R;
        voffA[i] = (unsigned)(R * g.lda + C) * 2u; voffB[i] = (unsigned)(Rb * K + C) * 2u; }
    const size_t kstep = (size_t)(BK * 2);
    const size_t hstepA = (size_t)HALF * g.lda * 2, hstepB = (size_t)HALF * K * 2;
    const size_t tstepA = 2 * hstepA, tstepB = 2 * hstepB;
    const unsigned ldsw = (unsigned)wid * 1024u;
    const int aoff = lds_byte(wr * 64 + fr, fq * 8), boff = lds_byte(wc * 32 + fr, fq * 8);
#define PG8_SA(b, h) (((b) * 2 + (h)) * HTB)
#define PG8_SB(b, h) ((4 + (b) * 2 + (h)) * HTB)
#define PG8_STAGE(bufoff, gbase, voff) do { _Pragma("unroll") for (int _i = 0; _i < 2; ++_i) \
        __builtin_amdgcn_global_load_lds((const unsigned*)((const char*)(gbase) + (voff)[_i]), (LAS unsigned*)(lds + (bufoff) + ldsw + _i * 8192), 16, 0, 0); } while (0)
#define PG8_LDA(dst, b, h) do { _Pragma("unroll") for (int m = 0; m < 4; ++m) _Pragma("unroll") for (int k = 0; k < 2; ++k) dst[m][k] = *(const LAS bf16x8*)(lds + PG8_SA(b, h) + aoff + m * 2048 + k * 1024); } while (0)
#define PG8_LDB(dst, b, h) do { _Pragma("unroll") for (int n = 0; n < 2; ++n) _Pragma("unroll") for (int k = 0; k < 2; ++k) dst[n][k] = *(const LAS bf16x8*)(lds + PG8_SB(b, h) + boff + n * 2048 + k * 1024); } while (0)
#define PG8_MMA(ai, bj, At, Bt) do { __builtin_amdgcn_s_setprio(1); _Pragma("unroll") for (int m = 0; m < 4; ++m) _Pragma("unroll") for (int n = 0; n < 2; ++n) _Pragma("unroll") for (int k = 0; k < 2; ++k) \
        acc[ai][bj][m][n] = __builtin_amdgcn_mfma_f32_16x16x32_bf16(Bt[n][k], At[m][k], acc[ai][bj][m][n], 0, 0, 0); __builtin_amdgcn_s_setprio(0); } while (0)
#define PG8_WAIT_V(n) asm volatile("s_waitcnt vmcnt(" #n ")" ::: "memory")
#define PG8_WAIT_L(n) asm volatile("s_waitcnt lgkmcnt(" #n ")" ::: "memory")
#define PG8_BAR __builtin_amdgcn_s_barrier()
#define PG8_SCHED __builtin_amdgcn_sched_barrier(0)
    Unit cur, nxt; int ui = 0;
    if (!S.next(0, cur)) return;
    f32x4 acc[2][2][4][2];
#pragma unroll
    for (int a = 0; a < 2; ++a)
#pragma unroll
        for (int b = 0; b < 2; ++b)
#pragma unroll
            for (int m = 0; m < 4; ++m)
#pragma unroll
                for (int n = 0; n < 2; ++n) acc[a][b][m][n] = (f32x4){0.f, 0.f, 0.f, 0.f};
    bf16x8 At[4][2], B0[2][2], B1[2][2];
    const char* cA = (const char*)g.A + (size_t)cur.pm * tstepA; const char* cB = (const char*)g.Bt + (size_t)cur.pn * tstepB;
    PG8_STAGE(PG8_SB(0, 0), cB, voffB); PG8_STAGE(PG8_SB(0, 1), cB + hstepB, voffB); PG8_STAGE(PG8_SA(0, 0), cA, voffA); PG8_STAGE(PG8_SA(0, 1), cA + hstepA, voffA);
    if (wr == 1) PG8_BAR;
    PG8_WAIT_V(2); PG8_BAR;
    PG8_STAGE(PG8_SB(1, 0), cB + kstep, voffB); PG8_STAGE(PG8_SA(1, 0), cA + kstep, voffA); PG8_STAGE(PG8_SB(1, 1), cB + hstepB + kstep, voffB);
    PG8_WAIT_V(6); PG8_BAR;
    for (;;) {
        const bool has_next = S.next(ui + 1, nxt);
        const char* nA = has_next ? (const char*)g.A + (size_t)nxt.pm * tstepA : cA; const char* nB = has_next ? (const char*)g.Bt + (size_t)nxt.pn * tstepB : cB;
        for (int t = 0; t < nt; t += 2) {
            const bool last = (t == nt - 2);
            const char* a1 = cA + (size_t)(t + 1) * kstep;
            const char* a2 = last ? nA : cA + (size_t)(t + 2) * kstep; const char* b2 = last ? nB : cB + (size_t)(t + 2) * kstep;
            const char* a3 = a2 + kstep; const char* b3 = b2 + kstep;
            PG8_LDB(B0, 0, 0); PG8_LDB(B1, 0, 1); PG8_SCHED; PG8_LDA(At, 0, 0); PG8_STAGE(PG8_SA(1, 1), a1 + hstepA, voffA);
            PG8_WAIT_V(8); PG8_WAIT_L(0); PG8_BAR; PG8_MMA(0, 0, At, B0); PG8_MMA(0, 1, At, B1); PG8_BAR; PG8_SCHED;
            PG8_LDA(At, 0, 1); PG8_STAGE(PG8_SB(0, 0), b2, voffB); PG8_STAGE(PG8_SB(0, 1), b2 + hstepB, voffB); PG8_STAGE(PG8_SA(0, 0), a2, voffA);
            PG8_WAIT_V(8); PG8_WAIT_L(0); PG8_BAR; PG8_MMA(1, 0, At, B0); PG8_MMA(1, 1, At, B1); PG8_BAR; PG8_SCHED;
            PG8_LDB(B0, 1, 0); PG8_LDB(B1, 1, 1); PG8_SCHED; PG8_LDA(At, 1, 0); PG8_STAGE(PG8_SA(0, 1), a2 + hstepA, voffA);
            PG8_WAIT_V(8); PG8_WAIT_L(0); PG8_BAR; PG8_MMA(0, 0, At, B0); PG8_MMA(0, 1, At, B1); PG8_BAR; PG8_SCHED;
            PG8_LDA(At, 1, 1); PG8_STAGE(PG8_SB(1, 0), b3, voffB); PG8_STAGE(PG8_SB(1, 1), b3 + hstepB, voffB); PG8_STAGE(PG8_SA(1, 0), a3, voffA);
            PG8_WAIT_V(8); PG8_WAIT_L(0); PG8_BAR; PG8_MMA(1, 0, At, B0); PG8_MMA(1, 1, At, B1); PG8_BAR; PG8_SCHED;
        }
        if (wr == 0) PG8_BAR;
        E(acc, cur, wr, wc, fr, fq);
        if (!has_next) break;
#pragma unroll
        for (int a = 0; a < 2; ++a)
#pragma unroll
            for (int b = 0; b < 2; ++b)
#pragma unroll
                for (int m = 0; m < 4; ++m)
#pragma unroll
                    for (int n = 0; n < 2; ++n) acc[a][b][m][n] = (f32x4){0.f, 0.f, 0.f, 0.f};
        cur = nxt; cA = nA; cB = nB; ++ui;
        if (wr == 1) PG8_BAR;
    }
    PG8_WAIT_V(0);
    PG8_BAR;
#undef PG8_SA
#undef PG8_SB
#undef PG8_STAGE
#undef PG8_LDA
#undef PG8_LDB
#undef PG8_MMA
#undef PG8_WAIT_V
#undef PG8_WAIT_L
#undef PG8_BAR
#undef PG8_SCHED
}
}

namespace att {
constexpr int NW = 8, QBLK = 32, KVBLK = 64;
constexpr float THR = 8.f;
constexpr int SHM_K = KVBLK * 256;
#define KSWZ(row, colB) ((row) * 256 + ((colB) ^ ((((row) & 7) | ((((row) >> 4) & 1) << 3)) << 4)))
#define SBAR() __builtin_amdgcn_sched_barrier(0)
__device__ __forceinline__ int crow(int r, int hi) { return (r & 3) + 8 * (r >> 2) + 4 * hi; }
template <int DQ> struct Sc { static constexpr float SCALE = (DQ == 96) ? 0.10206207261596575f : 0.08838834764831845f; };

template <int DQ, bool PRE>
__device__ __forceinline__ void partialSM(f32x16& p0, f32x16& p1, float& m_reg, float& mn, float& alpha) {
    constexpr float SCALE = PRE ? 0.6931471805599453f : Sc<DQ>::SCALE, C = SCALE * 1.4426950408889634f;
    float pmax = p0[0];
#pragma unroll
    for (int r = 1; r < 16; ++r) pmax = fmaxf(pmax, p0[r]);
#pragma unroll
    for (int r = 0; r < 16; ++r) pmax = fmaxf(pmax, p1[r]);
    { auto rr = __builtin_amdgcn_permlane32_swap(__float_as_uint(pmax), __float_as_uint(pmax), false, false);
      pmax = fmaxf(__uint_as_float(rr[0]), __uint_as_float(rr[1])); }
    if (__builtin_expect(__all(pmax - m_reg <= THR / SCALE), 1)) { mn = m_reg; alpha = 1.f; }
    else { mn = fmaxf(m_reg, pmax); alpha = __builtin_amdgcn_exp2f((m_reg - mn) * C); m_reg = mn; }
    const float mnC = -mn * C;
#pragma unroll
    for (int r = 0; r < 16; ++r) p0[r] = fmaf(p0[r], C, mnC);
#pragma unroll
    for (int r = 0; r < 16; ++r) p1[r] = fmaf(p1[r], C, mnC);
#pragma unroll
    for (int r = 0; r < 16; ++r) p0[r] = __builtin_amdgcn_exp2f(p0[r]);
}
__device__ __forceinline__ void finishSM(f32x16& p0, f32x16& p1, float alpha, float& l_reg, bf16x8& pa0, bf16x8& pa1, bf16x8& pa2, bf16x8& pa3) {
#pragma unroll
    for (int r = 0; r < 16; ++r) p1[r] = __builtin_amdgcn_exp2f(p1[r]);
    float ps = 0;
#pragma unroll
    for (int r = 0; r < 16; ++r) ps += p0[r];
#pragma unroll
    for (int r = 0; r < 16; ++r) ps += p1[r];
    { auto rr = __builtin_amdgcn_permlane32_swap(__float_as_uint(ps), __float_as_uint(ps), false, false);
      ps = __uint_as_float(rr[0]) + __uint_as_float(rr[1]); }
    l_reg = l_reg * alpha + ps;
#define PK4(P, BASE, OUT) do { unsigned a0 = cvtpk(P[BASE + 0], P[BASE + 1]), a1 = cvtpk(P[BASE + 2], P[BASE + 3]);   \
    unsigned b0 = cvtpk(P[BASE + 4], P[BASE + 5]), b1 = cvtpk(P[BASE + 6], P[BASE + 7]);                              \
    auto r0 = __builtin_amdgcn_permlane32_swap(a0, b0, false, false); auto r1 = __builtin_amdgcn_permlane32_swap(a1, b1, false, false); \
    u32x4 w = {r0[0], r1[0], r0[1], r1[1]}; OUT = *reinterpret_cast<bf16x8*>(&w); } while (0)
    PK4(p0, 0, pa0); PK4(p0, 8, pa1); PK4(p1, 0, pa2); PK4(p1, 8, pa3);
#undef PK4
}
__device__ __forceinline__ void fastSM0(f32x16& p0) {
#pragma unroll
    for (int r = 0; r < 16; ++r) p0[r] = __builtin_amdgcn_exp2f(p0[r]);
}
template <int DQ>
__device__ __forceinline__ void qkt(f32x16& p0, f32x16& p1, const char* Ks, const bf16x8* qr, int r32, int hi, float init) {
#pragma unroll
    for (int r = 0; r < 16; ++r) { p0[r] = init; p1[r] = init; }
#pragma unroll
    for (int d0 = 0; d0 < DQ / 16; ++d0) { const int cb = (d0 * 16 + hi * 8) * 2;
        const bf16x8 b0 = *reinterpret_cast<const bf16x8*>(Ks + KSWZ(r32, cb));
        const bf16x8 b1 = *reinterpret_cast<const bf16x8*>(Ks + KSWZ(32 + r32, cb));
        p0 = __builtin_amdgcn_mfma_f32_32x32x16_bf16(b0, qr[d0], p0, 0, 0, 0);
        p1 = __builtin_amdgcn_mfma_f32_32x32x16_bf16(b1, qr[d0], p1, 0, 0, 0);
        if (DQ == 128 && d0 == 3) SBAR(); }
}
template <int DV> __device__ __forceinline__ int v_st(int k, int c) { const int kk = (k & ~0xC) | ((k & 4) << 1) | ((k & 8) >> 1); return ((kk >> 3) * (DV / 32) + (c >> 5)) * 512 + ((kk & 7) * 32 + (c & 31)) * 2; }
__device__ __forceinline__ int v_rd_base(int lane) { return ((lane & 3) << 3) | (((lane >> 2) & 3) << 6) | (((lane >> 4) & 1) << 5) | (((lane >> 5) & 1) << 8); }
template <int DV> constexpr int v_rd_off(int d0, int ks, int half) { return d0 * 512 + ks * (4096 * DV / 128) + half * (2048 * DV / 128); }
template <int OFF> __device__ __forceinline__ s16x4 tr_read(int vb) {
    s16x4 r; asm volatile("ds_read_b64_tr_b16 %0, %1 offset:%2" : "=&v"(r) : "v"(vb), "i"(OFF) : "memory"); return r;
}
template <int DV, int D0> __device__ __forceinline__ void pv_one(f32x16& od, int vb, bf16x8 pa0, bf16x8 pa1, bf16x8 pa2, bf16x8 pa3) {
    const s16x4 l0 = tr_read<v_rd_off<DV>(D0, 0, 0)>(vb), h0 = tr_read<v_rd_off<DV>(D0, 0, 1)>(vb), l1 = tr_read<v_rd_off<DV>(D0, 1, 0)>(vb), h1 = tr_read<v_rd_off<DV>(D0, 1, 1)>(vb);
    const s16x4 l2 = tr_read<v_rd_off<DV>(D0, 2, 0)>(vb), h2 = tr_read<v_rd_off<DV>(D0, 2, 1)>(vb), l3 = tr_read<v_rd_off<DV>(D0, 3, 0)>(vb), h3 = tr_read<v_rd_off<DV>(D0, 3, 1)>(vb);
    asm volatile("s_waitcnt lgkmcnt(0)" ::: "memory"); SBAR();
#define PK(L, H) (bf16x8){L[0], L[1], L[2], L[3], H[0], H[1], H[2], H[3]}
    od = __builtin_amdgcn_mfma_f32_32x32x16_bf16(pa0, PK(l0, h0), od, 0, 0, 0);
    od = __builtin_amdgcn_mfma_f32_32x32x16_bf16(pa1, PK(l1, h1), od, 0, 0, 0);
    od = __builtin_amdgcn_mfma_f32_32x32x16_bf16(pa2, PK(l2, h2), od, 0, 0, 0);
    od = __builtin_amdgcn_mfma_f32_32x32x16_bf16(pa3, PK(l3, h3), od, 0, 0, 0);
#undef PK
}
template <int DV> __device__ __forceinline__ void pv_all(f32x16* o, int vb, bf16x8 pa0, bf16x8 pa1, bf16x8 pa2, bf16x8 pa3) {
    pv_one<DV, 0>(o[0], vb, pa0, pa1, pa2, pa3); pv_one<DV, 1>(o[1], vb, pa0, pa1, pa2, pa3);
    if constexpr (DV == 128) { pv_one<DV, 2>(o[2], vb, pa0, pa1, pa2, pa3); pv_one<DV, 3>(o[3], vb, pa0, pa1, pa2, pa3); }
}

template <int DQ, int DV, int SD, int ldq, int ldo, bool PRE, bool FAST>
__device__ __forceinline__ void attn_unit(const bf16_t* Qb, const bf16_t* Kh, const bf16_t* Vh, bf16_t* OG, int seq, char* lds, const int tid, const float* qn, float kmax) {
    constexpr int NQ = DQ / 16, NO = DV / 32, SHM_V = KVBLK * DV * 2;
    constexpr int KCH = DQ / 8, VCH = DV / 8;
    constexpr int NVI = KVBLK * VCH / 512;
    constexpr bool K2ALL = (KVBLK * KCH == 1024);
    const int wid = tid >> 6, lane = tid & 63, r32 = lane & 31, hi = lane >> 5;
    char* V_lds = lds; char* K_lds = lds + 2 * SHM_V;
    float* wsf = (float*)(lds + 2 * SHM_V + 2 * SHM_K) + wid * 64; float* li_l = wsf; float* al_l = wsf + 32;
    float m_reg = -1e30f, l_reg = 0; f32x16 o[NO]; bf16x8 qr[NQ];
    float negm = 0.f; if constexpr (FAST) negm = -(qn[(wid * QBLK + r32) * 8] * kmax);
#pragma unroll
    for (int d = 0; d < NO; ++d) o[d] = f32x16{};
    const bf16_t* Qw = Qb + (size_t)(wid * QBLK + r32) * ldq + hi * 8;
#pragma unroll
    for (int d0 = 0; d0 < NQ; ++d0) qr[d0] = *reinterpret_cast<const bf16x8*>(Qw + d0 * 16);
    const int kc0 = tid, kc1 = tid + 512;
    const int kl0 = KSWZ(kc0 / KCH, (kc0 % KCH) * 16), kl1 = KSWZ(kc1 / KCH, (kc1 % KCH) * 16);
    const bool k1on = K2ALL || (wid < 4);
    const int vl0 = v_st<DV>(tid / VCH, (tid % VCH) * 8), vl1 = v_st<DV>((tid + 512) / VCH, ((tid + 512) % VCH) * 8);
    const int vb0 = (int)(uintptr_t)V_lds + v_rd_base(lane);
    struct Slot { bf16x8 v0, v1, k0, k1; }; Slot sA, sB2; Slot& sB = (SD == 2) ? sB2 : sA;
#define SLOAD(S, key0) do { const bf16_t* kp_ = Kh + (size_t)(key0) * DQ; const bf16_t* vp_ = Vh + (size_t)(key0) * DV; \
        S.v0 = *reinterpret_cast<const bf16x8*>(vp_ + tid * 8); if constexpr (NVI == 2) S.v1 = *reinterpret_cast<const bf16x8*>(vp_ + (tid + 512) * 8); \
        S.k0 = *reinterpret_cast<const bf16x8*>(kp_ + kc0 * 8); if (k1on) S.k1 = *reinterpret_cast<const bf16x8*>(kp_ + kc1 * 8); } while (0)
#define SWRITE(b, S) do { *(bf16x8*)(V_lds + (b) * SHM_V + vl0) = S.v0; if constexpr (NVI == 2) *(bf16x8*)(V_lds + (b) * SHM_V + vl1) = S.v1; \
        *(bf16x8*)(K_lds + (b) * SHM_K + kl0) = S.k0; if (k1on) *(bf16x8*)(K_lds + (b) * SHM_K + kl1) = S.k1; } while (0)
#define RESC(a) do { if (__any((a) < 1.f)) { if (hi == 0) al_l[r32] = (a); asm volatile("s_waitcnt lgkmcnt(0)" ::: "memory"); \
        _Pragma("unroll") for (int d = 0; d < NO; ++d) _Pragma("unroll") for (int r = 0; r < 16; ++r) o[d][r] *= al_l[crow(r, hi)]; } } while (0)
    f32x16 pA0, pA1, pB0, pB1; float mnA, mnB, alA, alB; bf16x8 pa0, pa1, pa2, pa3; const int NT = seq / KVBLK;
    SLOAD(sA, 0); SWRITE(0, sA); __syncthreads();
#define PSM(P0, P1, MN, AL) do { if constexpr (FAST) { fastSM0(P0); AL = 1.f; } else partialSM<DQ, PRE>(P0, P1, m_reg, MN, AL); } while (0)
#define RESCX(a) do { if constexpr (!FAST) RESC(a); } while (0)
    qkt<DQ>(pA0, pA1, K_lds, qr, r32, hi, negm); PSM(pA0, pA1, mnA, alA);
    SLOAD(sB, KVBLK); if (SD == 2 && 2 < NT) SLOAD(sA, 2 * KVBLK);
    SWRITE(1, sB); __syncthreads();
    for (int j = 1; j + 1 < NT; j += 2) {
        SBAR(); qkt<DQ>(pB0, pB1, K_lds + SHM_K, qr, r32, hi, negm);
        finishSM(pA0, pA1, alA, l_reg, pa0, pa1, pa2, pa3); SBAR();
        SLOAD(sB, (j + SD) * KVBLK); SBAR();
        pv_all<DV>(o, vb0, pa0, pa1, pa2, pa3); PSM(pB0, pB1, mnB, alB);
        __syncthreads(); SWRITE(0, sA);
        RESCX(alB); __syncthreads();
        SBAR(); qkt<DQ>(pA0, pA1, K_lds, qr, r32, hi, negm);
        finishSM(pB0, pB1, alB, l_reg, pa0, pa1, pa2, pa3); SBAR();
        if (SD == 1 || j + 3 < NT) SLOAD(sA, (j + 1 + SD) * KVBLK); SBAR();
        pv_all<DV>(o, vb0 + SHM_V, pa0, pa1, pa2, pa3); PSM(pA0, pA1, mnA, alA);
        __syncthreads(); SWRITE(1, sB);
        RESCX(alA); __syncthreads();
    }
    SBAR(); qkt<DQ>(pB0, pB1, K_lds + SHM_K, qr, r32, hi, negm);
    finishSM(pA0, pA1, alA, l_reg, pa0, pa1, pa2, pa3); SBAR();
    pv_all<DV>(o, vb0, pa0, pa1, pa2, pa3); PSM(pB0, pB1, mnB, alB);
    __syncthreads(); RESCX(alB);
    finishSM(pB0, pB1, alB, l_reg, pa0, pa1, pa2, pa3); SBAR();
    pv_all<DV>(o, vb0 + SHM_V, pa0, pa1, pa2, pa3);
#undef PSM
#undef RESCX
    if (hi == 0) li_l[r32] = l_reg; asm volatile("s_waitcnt lgkmcnt(0)" ::: "memory");
    float rli[16];
#pragma unroll
    for (int r = 0; r < 16; ++r) rli[r] = __builtin_amdgcn_rcpf(li_l[crow(r, hi)]);
    bf16_t* Ow = OG + (size_t)(wid * QBLK) * ldo + r32;
    float gte[NO][16];
#pragma unroll
    for (int r = 0; r < 16; ++r)
#pragma unroll
        for (int d0 = 0; d0 < NO; ++d0) gte[d0][r] = bf1(Ow[(size_t)crow(r, hi) * ldo + d0 * 32]);
#pragma unroll
    for (int r = 0; r < 16; ++r)
#pragma unroll
        for (int d0 = 0; d0 < NO; ++d0) Ow[(size_t)crow(r, hi) * ldo + d0 * 32] = (bf16_t)(cvtpk(o[d0][r] * rli[r] * gte[d0][r], 0.f) & 0xffffu);
    __syncthreads();
#undef SLOAD
#undef SWRITE
#undef RESC
}

template <int ldq, int ldo>
__device__ __forceinline__ void attn_fast3(const bf16_t* Qb, const bf16_t* Kh, const bf16_t* Vh, bf16_t* OG, int seq, char* lds, const int tid, const float* qn, float kmax) {
    constexpr int DQ = 96, DV = 64, NQ = DQ / 16, NO = DV / 32, SHM_V = KVBLK * DV * 2, KCH = DQ / 8, VCH = DV / 8;
    const int wid = tid >> 6, lane = tid & 63, r32 = lane & 31, hi = lane >> 5;
    char* K_lds = lds; char* V_lds = lds + 3 * SHM_K;
    float* li_l = (float*)(lds + 3 * SHM_K + 3 * SHM_V) + wid * 64;
    float l_reg = 0; f32x16 o[NO]; bf16x8 qr[NQ];
    const float negm = -(qn[(wid * QBLK + r32) * 8] * kmax);
#pragma unroll
    for (int d = 0; d < NO; ++d) o[d] = f32x16{};
    const bf16_t* Qw = Qb + (size_t)(wid * QBLK + r32) * ldq + hi * 8;
#pragma unroll
    for (int d0 = 0; d0 < NQ; ++d0) qr[d0] = *reinterpret_cast<const bf16x8*>(Qw + d0 * 16);
    const int kc0 = tid, kc1 = tid + 512;
    const int kl0 = KSWZ(kc0 / KCH, (kc0 % KCH) * 16), kl1 = KSWZ(kc1 / KCH, (kc1 % KCH) * 16);
    const bool k1on = (wid < 4);
    const int vl0 = v_st<DV>(tid / VCH, (tid % VCH) * 8);
    const int vb0 = (int)(uintptr_t)V_lds + v_rd_base(lane);
    struct Slot { bf16x8 v0, k0, k1; }; Slot sA, sB;
#define SLOAD3(S, key0) do { const bf16_t* kp_ = Kh + (size_t)(key0) * DQ; const bf16_t* vp_ = Vh + (size_t)(key0) * DV; \
        S.v0 = *reinterpret_cast<const bf16x8*>(vp_ + tid * 8); S.k0 = *reinterpret_cast<const bf16x8*>(kp_ + kc0 * 8); if (k1on) S.k1 = *reinterpret_cast<const bf16x8*>(kp_ + kc1 * 8); } while (0)
#define SWRITE3(b, S) do { *(bf16x8*)(V_lds + (b) * SHM_V + vl0) = S.v0; *(bf16x8*)(K_lds + (b) * SHM_K + kl0) = S.k0; if (k1on) *(bf16x8*)(K_lds + (b) * SHM_K + kl1) = S.k1; } while (0)
    f32x16 pA0, pA1, pB0, pB1; bf16x8 pa0, pa1, pa2, pa3; const int NT = seq / KVBLK;
    SLOAD3(sA, 0); SLOAD3(sB, KVBLK); SWRITE3(0, sA); SWRITE3(1, sB); SLOAD3(sA, 2 * KVBLK); __syncthreads();
    qkt<DQ>(pA0, pA1, K_lds, qr, r32, hi, negm); fastSM0(pA0);
#define STEP3(PQ0, PQ1, PF0, PF1, SL, SW, J, BX, BY, BZ, DOLOAD, DOWRITE) do { \
        SBAR(); qkt<DQ>(PQ0, PQ1, K_lds + (BY) * SHM_K, qr, r32, hi, negm); \
        { float al_ = 1.f; finishSM(PF0, PF1, al_, l_reg, pa0, pa1, pa2, pa3); } __builtin_amdgcn_sched_group_barrier(0x100, 12, 0); SBAR(); \
        if (DOLOAD) SLOAD3(SL, ((J) + 3) * KVBLK); SBAR(); \
        pv_all<DV>(o, vb0 + (BX) * SHM_V, pa0, pa1, pa2, pa3); fastSM0(PQ0); \
        if (DOWRITE) SWRITE3(BZ, SW); \
        __syncthreads(); } while (0)
    int j = 0;
    for (; j + 6 < NT - 3; j += 6) {
        STEP3(pB0, pB1, pA0, pA1, sB, sA, j + 0, 0, 1, 2, true, true);
        STEP3(pA0, pA1, pB0, pB1, sA, sB, j + 1, 1, 2, 0, true, true);
        STEP3(pB0, pB1, pA0, pA1, sB, sA, j + 2, 2, 0, 1, true, true);
        STEP3(pA0, pA1, pB0, pB1, sA, sB, j + 3, 0, 1, 2, true, true);
        STEP3(pB0, pB1, pA0, pA1, sB, sA, j + 4, 1, 2, 0, true, true);
        STEP3(pA0, pA1, pB0, pB1, sA, sB, j + 5, 2, 0, 1, true, true);
    }
    STEP3(pB0, pB1, pA0, pA1, sB, sA, j + 0, 0, 1, 2, true, true);
    STEP3(pA0, pA1, pB0, pB1, sA, sB, j + 1, 1, 2, 0, false, true);
    STEP3(pB0, pB1, pA0, pA1, sB, sA, j + 2, 2, 0, 1, false, false);
    SBAR(); { float al_ = 1.f; finishSM(pB0, pB1, al_, l_reg, pa0, pa1, pa2, pa3); } SBAR();
    pv_all<DV>(o, vb0 + 0 * SHM_V, pa0, pa1, pa2, pa3);
#undef STEP3
#undef SLOAD3
#undef SWRITE3
    if (hi == 0) li_l[r32] = l_reg; asm volatile("s_waitcnt lgkmcnt(0)" ::: "memory");
    float rli[16];
#pragma unroll
    for (int r = 0; r < 16; ++r) rli[r] = __builtin_amdgcn_rcpf(li_l[crow(r, hi)]);
    bf16_t* Ow = OG + (size_t)(wid * QBLK) * ldo + r32;
    float gte[NO][16];
#pragma unroll
    for (int r = 0; r < 16; ++r)
#pragma unroll
        for (int d0 = 0; d0 < NO; ++d0) gte[d0][r] = bf1(Ow[(size_t)crow(r, hi) * ldo + d0 * 32]);
#pragma unroll
    for (int r = 0; r < 16; ++r)
#pragma unroll
        for (int d0 = 0; d0 < NO; ++d0) Ow[(size_t)crow(r, hi) * ldo + d0 * 32] = (bf16_t)(cvtpk(o[d0][r] * rli[r] * gte[d0][r], 0.f) & 0xffffu);
    __syncthreads();
}

template <int ldq, int ldo>
__device__ __forceinline__ void attn_dma4(const bf16_t* Qb, const bf16_t* Kh, const bf16_t* Vh, bf16_t* OG, int seq, char* lds, const int tid, const float* qn, float kmax) {
    constexpr int DQ = 96, DV = 64, NQ = DQ / 16, NO = DV / 32, SHM_V = KVBLK * DV * 2;
    const int wid = __builtin_amdgcn_readfirstlane(tid >> 6), lane = tid & 63, r32 = lane & 31, hi = lane >> 5;
    char* K_lds = lds; char* V_lds = lds + 4 * SHM_K;
    LAS unsigned char* Kl = (LAS unsigned char*)lds; LAS unsigned char* Vl = Kl + 4 * SHM_K;
    float* li_l = (float*)(lds + 4 * SHM_K + 4 * SHM_V) + wid * 64;
    float l_reg = 0; f32x16 o[NO]; bf16x8 qr[NQ];
    const float negm = -(qn[(wid * QBLK + r32) * 8] * kmax);
#pragma unroll
    for (int d = 0; d < NO; ++d) o[d] = f32x16{};
    const bf16_t* Qw = Qb + (size_t)(wid * QBLK + r32) * ldq + hi * 8;
#pragma unroll
    for (int d0 = 0; d0 < NQ; ++d0) qr[d0] = *reinterpret_cast<const bf16x8*>(Qw + d0 * 16);
    int kofs0, kofs1, vofs;
    { const int rowa = 4 * wid + (lane >> 4), rowb = rowa + 32, slot = lane & 15;
      const int fa = (rowa & 7) | (((rowa >> 4) & 1) << 3), fb = (rowb & 7) | (((rowb >> 4) & 1) << 3);
      const int ca = slot ^ fa, cb = slot ^ fb;
      kofs0 = rowa * DQ + (ca < 12 ? ca * 8 : 0); kofs1 = rowb * DQ + (cb < 12 ? cb * 8 : 0);
      const int sidx = wid * 64 + lane, sub = sidx >> 5, within = sidx & 31, kk = (sub >> 1) * 8 + (within >> 2), cc = (sub & 1) * 32 + (within & 3) * 8;
      const int key = (kk & ~0xC) | ((kk & 4) << 1) | ((kk & 8) >> 1);
      vofs = key * DV + cc; }
    const int vb0 = (int)(uintptr_t)V_lds + v_rd_base(lane);
#define DMA_TILE(T, SLOT) do { const bf16_t* kp_ = Kh + (size_t)(T) * (KVBLK * DQ); const bf16_t* vp_ = Vh + (size_t)(T) * (KVBLK * DV); \
        __builtin_amdgcn_global_load_lds((const unsigned*)(kp_ + kofs0), (LAS unsigned*)(Kl + (SLOT) * SHM_K + wid * 1024), 16, 0, 0); \
        __builtin_amdgcn_global_load_lds((const unsigned*)(kp_ + kofs1), (LAS unsigned*)(Kl + (SLOT) * SHM_K + 8192 + wid * 1024), 16, 0, 0); \
        __builtin_amdgcn_global_load_lds((const unsigned*)(vp_ + vofs), (LAS unsigned*)(Vl + (SLOT) * SHM_V + wid * 1024), 16, 0, 0); } while (0)
#define BAR_DMA(N) do { asm volatile("s_waitcnt vmcnt(" #N ")" ::: "memory"); asm volatile("s_waitcnt lgkmcnt(0)" ::: "memory"); __builtin_amdgcn_s_barrier(); asm volatile("" ::: "memory"); SBAR(); } while (0)
    f32x16 pA0, pA1, pB0, pB1; bf16x8 pa0, pa1, pa2, pa3; const int NT = seq / KVBLK;
    asm volatile("s_waitcnt lgkmcnt(0)" ::: "memory"); __builtin_amdgcn_s_barrier(); asm volatile("" ::: "memory");
    DMA_TILE(0, 0); DMA_TILE(1, 1); DMA_TILE(2, 2);
    BAR_DMA(3);
    qkt<DQ>(pA0, pA1, K_lds, qr, r32, hi, negm); fastSM0(pA0);
#define STEPD(PQ0, PQ1, PF0, PF1, J, S0, DOLOAD) do { \
        SBAR(); qkt<DQ>(PQ0, PQ1, K_lds + (((S0) + 1) & 3) * SHM_K, qr, r32, hi, negm); \
        { float al_ = 1.f; finishSM(PF0, PF1, al_, l_reg, pa0, pa1, pa2, pa3); } __builtin_amdgcn_sched_group_barrier(0x100, 12, 0); SBAR(); \
        if (DOLOAD) DMA_TILE((J) + 3, ((S0) + 3) & 3); SBAR(); \
        pv_all<DV>(o, vb0 + (S0) * SHM_V, pa0, pa1, pa2, pa3); fastSM0(PQ0); \
        if (DOLOAD) BAR_DMA(3); else BAR_DMA(0); } while (0)
    int j = 0;
    for (; j + 4 <= NT - 4; j += 4) {
        STEPD(pB0, pB1, pA0, pA1, j + 0, 0, true); STEPD(pA0, pA1, pB0, pB1, j + 1, 1, true);
        STEPD(pB0, pB1, pA0, pA1, j + 2, 2, true); STEPD(pA0, pA1, pB0, pB1, j + 3, 3, true);
    }
    STEPD(pB0, pB1, pA0, pA1, j + 0, 0, true);
    STEPD(pA0, pA1, pB0, pB1, j + 1, 1, false);
    STEPD(pB0, pB1, pA0, pA1, j + 2, 2, false);
    SBAR(); { float al_ = 1.f; finishSM(pB0, pB1, al_, l_reg, pa0, pa1, pa2, pa3); } SBAR();
    pv_all<DV>(o, vb0 + 3 * SHM_V, pa0, pa1, pa2, pa3);
#undef STEPD
#undef DMA_TILE
#undef BAR_DMA
    if (hi == 0) li_l[r32] = l_reg; asm volatile("s_waitcnt lgkmcnt(0)" ::: "memory");
    float rli[16];
#pragma unroll
    for (int r = 0; r < 16; ++r) rli[r] = __builtin_amdgcn_rcpf(li_l[crow(r, hi)]);
    bf16_t* Ow = OG + (size_t)(wid * QBLK) * ldo + r32;
    float gte[NO][16];
#pragma unroll
    for (int r = 0; r < 16; ++r)
#pragma unroll
        for (int d0 = 0; d0 < NO; ++d0) gte[d0][r] = bf1(Ow[(size_t)crow(r, hi) * ldo + d0 * 32]);
#pragma unroll
    for (int r = 0; r < 16; ++r)
#pragma unroll
        for (int d0 = 0; d0 < NO; ++d0) Ow[(size_t)crow(r, hi) * ldo + d0 * 32] = (bf16_t)(cvtpk(o[d0][r] * rli[r] * gte[d0][r], 0.f) & 0xffffu);
    __syncthreads();
}

template <int ldq, int ldo>
__device__ __forceinline__ void attn_mem(const bf16_t* Qb, const bf16_t* Kh, const bf16_t* Vh, bf16_t* OG, char* lds, const int tid) {
    constexpr int DQ = 128, DV = 128, NQ = DQ / 16, NO = DV / 32, SHM_V = KVBLK * DV * 2, NT = 4;
    const int wid = __builtin_amdgcn_readfirstlane(tid >> 6), lane = tid & 63, r32 = lane & 31, hi = lane >> 5;
    char* K_lds = lds; char* V_lds = lds + NT * SHM_K;
    LAS unsigned char* Kl = (LAS unsigned char*)lds; LAS unsigned char* Vl = Kl + NT * SHM_K;
    float* wsf = (float*)(lds + LDS_SCR_OFF) + wid * 64; float* li_l = wsf; float* al_l = wsf + 32;
    int kofs, vofs0, vofs1;
    { const int rowa = 4 * wid + (lane >> 4), slot = lane & 15, fa = (rowa & 7) | (((rowa >> 4) & 1) << 3);
      kofs = rowa * DQ + (slot ^ fa) * 8;
      const int s0 = wid * 64 + lane, s1 = (wid + 8) * 64 + lane;
      { const int sub = s0 >> 5, within = s0 & 31, kk = (sub >> 2) * 8 + (within >> 2), cc = (sub & 3) * 32 + (within & 3) * 8; vofs0 = ((kk & ~0xC) | ((kk & 4) << 1) | ((kk & 8) >> 1)) * DV + cc; }
      { const int sub = s1 >> 5, within = s1 & 31, kk = (sub >> 2) * 8 + (within >> 2), cc = (sub & 3) * 32 + (within & 3) * 8; vofs1 = ((kk & ~0xC) | ((kk & 4) << 1) | ((kk & 8) >> 1)) * DV + cc; } }
    const int vb0 = (int)(uintptr_t)V_lds + v_rd_base(lane);
    asm volatile("s_waitcnt lgkmcnt(0)" ::: "memory"); __builtin_amdgcn_s_barrier(); asm volatile("" ::: "memory");
#pragma unroll
    for (int i = 0; i < 8; ++i)
        __builtin_amdgcn_global_load_lds((const unsigned*)(Kh + kofs + i * 32 * DQ), (LAS unsigned*)(Kl + (wid + 8 * i) * 1024), 16, 0, 0);
#pragma unroll
    for (int t = 0; t < NT; ++t) {
        __builtin_amdgcn_global_load_lds((const unsigned*)(Vh + t * KVBLK * DV + vofs0), (LAS unsigned*)(Vl + t * SHM_V + wid * 1024), 16, 0, 0);
        __builtin_amdgcn_global_load_lds((const unsigned*)(Vh + t * KVBLK * DV + vofs1), (LAS unsigned*)(Vl + t * SHM_V + (wid + 8) * 1024), 16, 0, 0); }
    bf16x8 qr[NQ]; f32x16 o[NO]; float m_reg = -1e30f, l_reg = 0.f;
#pragma unroll
    for (int d = 0; d < NO; ++d) o[d] = f32x16{};
    const bf16_t* Qw = Qb + (size_t)(wid * QBLK + r32) * ldq + hi * 8;
#pragma unroll
    for (int d0 = 0; d0 < NQ; ++d0) qr[d0] = *reinterpret_cast<const bf16x8*>(Qw + d0 * 16);
    asm volatile("s_waitcnt vmcnt(0)" ::: "memory"); asm volatile("s_waitcnt lgkmcnt(0)" ::: "memory"); __builtin_amdgcn_s_barrier(); asm volatile("" ::: "memory"); SBAR();
    f32x16 p0, p1; bf16x8 pa0, pa1, pa2, pa3;
#pragma unroll
    for (int t = 0; t < NT; ++t) {
        float mn, al;
        qkt<DQ>(p0, p1, K_lds + t * SHM_K, qr, r32, hi, 0.f);
        partialSM<DQ, false>(p0, p1, m_reg, mn, al);
        if (__any(al < 1.f)) { if (hi == 0) al_l[r32] = al; asm volatile("s_waitcnt lgkmcnt(0)" ::: "memory");
#pragma unroll
            for (int d = 0; d < NO; ++d)
#pragma unroll
                for (int r = 0; r < 16; ++r) o[d][r] *= al_l[crow(r, hi)]; }
        finishSM(p0, p1, al, l_reg, pa0, pa1, pa2, pa3); SBAR();
        pv_all<DV>(o, vb0 + t * SHM_V, pa0, pa1, pa2, pa3);
    }
    if (hi == 0) li_l[r32] = l_reg; asm volatile("s_waitcnt lgkmcnt(0)" ::: "memory");
    float rli[16];
#pragma unroll
    for (int r = 0; r < 16; ++r) rli[r] = __builtin_amdgcn_rcpf(li_l[crow(r, hi)]);
    bf16_t* Ow = OG + (size_t)(wid * QBLK) * ldo + r32;
#pragma unroll
    for (int dh = 0; dh < 2; ++dh) {
        float gte[2][16];
#pragma unroll
        for (int r = 0; r < 16; ++r)
#pragma unroll
            for (int d0 = 0; d0 < 2; ++d0) gte[d0][r] = bf1(Ow[(size_t)crow(r, hi) * ldo + (2 * dh + d0) * 32]);
#pragma unroll
        for (int r = 0; r < 16; ++r)
#pragma unroll
            for (int d0 = 0; d0 < 2; ++d0) Ow[(size_t)crow(r, hi) * ldo + (2 * dh + d0) * 32] = (bf16_t)(cvtpk(o[2 * dh + d0][r] * rli[r] * gte[d0][r], 0.f) & 0xffffu);
        asm volatile("" ::: "memory"); }
    __syncthreads();
}
}

constexpr int NWAVES = 8;
constexpr int LDS_BYTES = 135168, LDS_CTL_OFF = 132096;

struct Params {
    const float* x; const float* mem; const int* pos;
    const float *norm_g, *w_in, *b_gate, *q_norm_g, *w_uq, *kv_norm_g, *w_ukv, *q_head_g, *k_head_g, *conv_w, *conv_b, *mem_norm_g, *w_mkv, *mem_q_g, *mem_k_g,
                *w_br_attn, *w_br_conv, *w_br_mem, *w_out;
    float* out; unsigned char* ws;
    float inv_freq[16];
};

__device__ __forceinline__ void transpose_item(const float* W, int ldn, int K, const float* gain, bf16_t* WT, int k0, int n0src, int dstrow, LAS float* scr, int lane) {
#pragma unroll
    for (int i = 0; i < 8; ++i) { const int kk = 8 * i + (lane >> 3), c4 = (lane & 7) * 4; const float gn = gain ? gain[k0 + kk] : 1.f;
        const f32x4 v = *(const f32x4*)(W + (size_t)(k0 + kk) * ldn + n0src + c4);
        scr[kk * 33 + c4 + 0] = v.x * gn; scr[kk * 33 + c4 + 1] = v.y * gn; scr[kk * 33 + c4 + 2] = v.z * gn; scr[kk * 33 + c4 + 3] = v.w * gn; }
    asm volatile("s_waitcnt lgkmcnt(0)" ::: "memory");
    const int c = lane & 7;
#pragma unroll
    for (int j = 0; j < 4; ++j) { const int n = (lane >> 3) + 8 * j; const LAS float* s = scr + (8 * c) * 33 + n;
        u32x4 o; o.x = cvtpk(s[0 * 33], s[1 * 33]); o.y = cvtpk(s[2 * 33], s[3 * 33]); o.z = cvtpk(s[4 * 33], s[5 * 33]); o.w = cvtpk(s[6 * 33], s[7 * 33]);
        *(u32x4*)(WT + (size_t)(dstrow + n) * K + k0 + 8 * c) = o; }
    asm volatile("s_waitcnt lgkmcnt(0)" ::: "memory");
}
__device__ __forceinline__ int win_dst_col(int n) {
    if (n < 384) return C_QLAT + n;
    if (n < 640) return C_KVLAT + (n - 384);
    if (n < 672) return C_KPE + (n - 640);
    if (n < 1184) return C_CB + (n - 672);
    if (n < 1696) return C_CC + (n - 1184);
    if (n < 2208) return C_CU + (n - 1696);
    if (n < 2720) return C_QMEM + (n - 2208);
    if (n < 3232) return C_GATTN + (n - 2720);
    if (n < 3744) return C_GCONV + (n - 3232);
    if (n < 4256) return C_GMEM + (n - 3744);
    return n - 4256;
}
__device__ __forceinline__ void rows_to_bf16(const float* xin, bf16_t* xb, float* rstd, int rows, int gw, int NGW, int lane) {
    for (int m = gw; m < rows; m += NGW) {
        const f32x4* xr = (const f32x4*)(xin + (size_t)m * 1024) + lane;
        f32x4 v[4]; float s = 0.f;
#pragma unroll
        for (int j = 0; j < 4; ++j) { v[j] = xr[64 * j]; s += (v[j].x * v[j].x + v[j].y * v[j].y) + (v[j].z * v[j].z + v[j].w * v[j].w); }
        s = wave_sum(s);
        if (lane == 0) rstd[m] = rsqrtf(s * (1.f / 1024.f) + EPS);
        u32x2* o8 = (u32x2*)(xb + (size_t)m * 1024) + lane;
#pragma unroll
        for (int j = 0; j < 4; ++j) { u32x2 w; w.x = cvtpk(v[j].x, v[j].y); w.y = cvtpk(v[j].z, v[j].w); o8[64 * j] = w; }
    }
}

#define XB_TMO      128
#define XB_XCNT(j)  (256  + 64 * (j))
#define XB_XSUB(j)  (1280 + 64 * (j))
#define XB_XGEN(j)  (2304 + 64 * (j))
#define XB_TOP      3328
#define XB_TOPGEN   3392
#define XCD_BAR_WORDS 3456
#define XB_SPIN_CAP (1u << 18)
__device__ __forceinline__ unsigned xb_ld(unsigned* p)              { return __hip_atomic_load(p, __ATOMIC_RELAXED, __HIP_MEMORY_SCOPE_AGENT); }
__device__ __forceinline__ unsigned xb_add(unsigned* p, unsigned v) { return __hip_atomic_fetch_add(p, v, __ATOMIC_RELAXED, __HIP_MEMORY_SCOPE_AGENT); }
__device__ __forceinline__ unsigned xb_xcc_id() { return (unsigned)__builtin_amdgcn_s_getreg((3 << 11) | 20) & 0xFu; }
#define XB_SPIN(cond, bar) do { unsigned _sp = 0; while (cond) { __builtin_amdgcn_s_sleep(1); \
    if ((++_sp & 255u) == 0u) { if (xb_ld(&(bar)[XB_TMO])) break; if (_sp > XB_SPIN_CAP) { atomicAdd(&(bar)[XB_TMO], 1u); break; } } } } while (0)
struct XcdBarrier { unsigned* bar; unsigned x; volatile LAS unsigned* st; };
__device__ __forceinline__ XcdBarrier xcd_barrier_post(unsigned* bar, volatile LAS unsigned* st) {
    XcdBarrier b; b.bar = bar; b.x = xb_xcc_id(); b.st = st;
    if (threadIdx.x == 0) (void)xb_add(&bar[XB_XCNT(b.x)], 1u);
    return b;
}
__device__ __forceinline__ void xcd_barrier_complete(unsigned* bar, unsigned x, unsigned& nloc, unsigned& nx) {
    const unsigned G = gridDim.x * gridDim.y * gridDim.z;
    unsigned sum, cnt, mine, sp = 0u;
    for (;;) {
        sum = 0u; cnt = 0u; mine = 0u;
#pragma unroll
        for (unsigned j = 0; j < 16; ++j) { const unsigned c = xb_ld(&bar[XB_XCNT(j)]); sum += c; cnt += (c > 0u) ? 1u : 0u; mine = (j == x) ? c : mine; }
        if (sum == G) break;
        __builtin_amdgcn_s_sleep(1);
        if ((++sp & 255u) == 0u) { if (xb_ld(&bar[XB_TMO])) break; if (sp > XB_SPIN_CAP) { atomicAdd(&bar[XB_TMO], 1u); break; } }
    }
    nloc = mine > 0u ? mine : 1u; nx = cnt > 0u ? cnt : 1u;
}
__device__ __forceinline__ void xcd_barrier(const XcdBarrier& b) {
    asm volatile("s_waitcnt vmcnt(0)" ::: "memory");
    __syncthreads();
    if (threadIdx.x == 0) {
        unsigned* bar = b.bar;
        __builtin_amdgcn_s_waitcnt(0);
        unsigned nloc = b.st[0], nx = b.st[1];
        if (nloc == 0u) { xcd_barrier_complete(bar, b.x, nloc, nx); b.st[0] = nloc; b.st[1] = nx; }
        const unsigned old = xb_add(&bar[XB_XSUB(b.x)], 1u);
        const unsigned gen = old / nloc;
        if (old + 1u == (gen + 1u) * nloc) {
            __builtin_amdgcn_fence(__ATOMIC_RELEASE, "agent");
            asm volatile("s_waitcnt vmcnt(0)" ::: "memory");
            const unsigned og = xb_add(&bar[XB_TOP], 1u);
            const unsigned tg = og / nx;
            if (og + 1u == (tg + 1u) * nx) xb_add(&bar[XB_TOPGEN], 1u);
            else XB_SPIN(xb_ld(&bar[XB_TOPGEN]) == tg, bar);
            __builtin_amdgcn_fence(__ATOMIC_ACQUIRE, "agent");
            xb_add(&bar[XB_XGEN(b.x)], 1u);
            asm volatile("s_waitcnt vmcnt(0)" ::: "memory");
        } else {
            XB_SPIN(xb_ld(&bar[XB_XGEN(b.x)]) == gen, bar);
            __builtin_amdgcn_fence(__ATOMIC_ACQUIRE, "agent");
            asm volatile("s_waitcnt vmcnt(0)" ::: "memory");
        }
    }
    __syncthreads();
}

enum { K_S0 = 0, K_S2, K_ROWS, K_CONV, K_QKV, K_MATT, K_ATT, K_NOP, K_G_MKV, K_G_IN, K_G_UQ, K_G_UKV, K_G_BC, K_G_BM, K_G_BA, K_G_OUT };
constexpr int STEPS_PER = 11, N_ITERS = DEPTH * NB, N_STEPS = 3 + N_ITERS * STEPS_PER + 1;
__host__ __device__ __forceinline__ int step_kind(int s) {
    return s == 0 ? K_G_OUT : s == 1 ? K_G_IN : s == 2 ? K_G_UQ : s == 3 ? K_G_UKV : s == 4 ? K_CONV : s == 5 ? K_QKV : s == 6 ? K_MATT : s == 7 ? K_G_BC : s == 8 ? K_G_BM : s == 9 ? K_ATT : K_G_BA;
}
__host__ __device__ __forceinline__ bool step_sync(int s) { return (0x652 >> s) & 1; }

__global__ void __launch_bounds__(NWAVES * 64, 2) mega(Params p, int lo, int hi) {
    extern __shared__ __attribute__((aligned(16))) unsigned char lds[];
    cg::grid_group grid = cg::this_grid();
    LAS unsigned char* ldsl = (LAS unsigned char*)lds;
    const int G = gridDim.x, bx = blockIdx.x, NGW = G * NWAVES;
    unsigned char* ws = p.ws;
    bf16_t* WMKV = (bf16_t*)(ws + WS_WMKV); bf16_t* MEMB = (bf16_t*)(ws + WS_MEMB); bf16_t* MKVRAW = (bf16_t*)(ws + WS_MKVRAW);
    bf16_t* MK = (bf16_t*)(ws + WS_MK); bf16_t* MV = (bf16_t*)(ws + WS_MV); float* MRSTD = (float*)(ws + WS_MRSTD); float* RSTD = (float*)(ws + WS_RSTD);
    bf16_t* XB = (bf16_t*)(ws + WS_XB); bf16_t* PROJ = (bf16_t*)(ws + WS_PROJ); bf16_t* QRAW = (bf16_t*)(ws + WS_QRAW); bf16_t* KVRAW = (bf16_t*)(ws + WS_KVRAW);
    float* QN = (float*)(ws + WS_QN); float* KQMAX = (float*)(ws + WS_KQMAX);
    bf16_t* QF = (bf16_t*)(ws + WS_QF); bf16_t* KF = (bf16_t*)(ws + WS_KF); bf16_t* VF = (bf16_t*)(ws + WS_VF);
    if (threadIdx.x < 4) ((volatile LAS unsigned*)(ldsl + LDS_CTL_OFF))[threadIdx.x] = 0u;
    __syncthreads();
    const XcdBarrier xbar = xcd_barrier_post((unsigned*)(ws + WS_BAR), (volatile LAS unsigned*)(ldsl + LDS_CTL_OFF));
    for (int st = lo; st < hi; ++st) {
        int tidv = threadIdx.x; asm volatile("" : "+v"(tidv));
        const int tid = tidv, lane = tid & 63, wave = __builtin_amdgcn_readfirstlane(tid >> 6), gw = bx * NWAVES + wave;
        int kind, l = 0, b = 0; bool sync_after = true;
        if (st < 3) kind = (st == 0) ? K_S0 : (st == 1 ? K_G_MKV : K_S2);
        else { const int r = st - 3; int it;
            if (r == N_ITERS * STEPS_PER) { kind = K_G_OUT; it = N_ITERS - 1; }
            else { it = r / STEPS_PER; const int sidx = r % STEPS_PER; kind = step_kind(sidx); sync_after = step_sync(sidx);
                   if (sidx == 0) { if (it == 0) kind = K_NOP; else it -= 1; } }
            l = it >> 1; b = it & 1; }
        unsigned char* lw = ws + WS_LW + (size_t)l * LW_SIZE;
        const float* xin = (l == 0 ? p.x : (const float*)p.out) + (size_t)b * SEQ * 1024;
        float* xout = p.out + (size_t)b * SEQ * 1024;

#ifndef NO_GEMM
        if (kind >= K_G_MKV) {
            bf16_t* YB = KVRAW;
            pg8::Gemm g; pg8::EpiRT E; E.ldr = PJ; E.mode = 0; E.O = nullptr; E.ldc = PJ; E.rstd = nullptr; E.bias = nullptr; E.R = nullptr; E.Xin = nullptr; E.Xout = nullptr;
            g.M = SEQ; g.N = 1024; g.K = 512; g.lda = PJ;
            if (kind == K_G_MKV)      { g.A = MEMB; g.Bt = WMKV; g.M = NB * MEML; g.N = DEPTH * 1024; g.K = 1024; g.lda = 1024; E.O = MKVRAW; E.ldc = DEPTH * 1024; E.rstd = MRSTD; }
            else if (kind == K_G_IN)  { g.A = XB; g.Bt = (const bf16_t*)(lw + LW_WIN); g.N = PJ; g.K = 1024; g.lda = 1024; E.mode = 1; E.O = PROJ; E.rstd = RSTD; E.bias = p.b_gate + l * 3072; }
            else if (kind == K_G_UQ)  { g.A = PROJ + C_QLAT; g.Bt = (const bf16_t*)(lw + LW_WUQ); g.N = 768; g.K = 384; E.O = QRAW; E.ldc = 768; }
            else if (kind == K_G_UKV) { g.A = PROJ + C_KVLAT; g.Bt = (const bf16_t*)(lw + LW_WUKV); g.N = 1024; g.K = 256; E.O = KVRAW; E.ldc = 1024; }
            else if (kind == K_G_BC)  { g.A = PROJ + C_CB; g.Bt = (const bf16_t*)(lw + LW_WBC); E.mode = 2; E.O = YB; E.ldc = 1024; E.R = PROJ + C_RCONV; }
            else if (kind == K_G_BM)  { g.A = PROJ + C_GMEM; g.Bt = (const bf16_t*)(lw + LW_WBM); E.mode = 3; E.O = YB; E.ldc = 1024; E.R = PROJ + C_RMEM; }
            else if (kind == K_G_BA)  { g.A = PROJ + C_GATTN; g.Bt = (const bf16_t*)(lw + LW_WBA); E.mode = 3; E.O = YB; E.ldc = 1024; E.R = PROJ + C_RATTN; }
            else                      { g.A = YB; g.lda = 1024; g.Bt = (const bf16_t*)(lw + LW_WOUT); g.K = 1024; E.mode = 4; E.Xin = xin; E.Xout = xout; }
            pg8::StaticOrder S; S.init(g.M, g.N, G, bx);
            pg8::gemm_phase(ldsl, g, S, E, tid);
            if (kind == K_G_BA && (l * 2 + b) + 1 < DEPTH * NB) {
                const int ln = (l * 2 + b + 1) >> 1, bn = (l * 2 + b + 1) & 1;
                const float* xn = (ln == 0 ? p.x : (const float*)p.out) + (size_t)bn * SEQ * 1024;
                __syncthreads();
                rows_to_bf16(xn, XB, RSTD, SEQ, gw, NGW, lane);
                if (bx == 0 && tid < 16) KQMAX[tid] = 0.f;
            }
        }
#endif
#ifndef ONLY_GEMM
        if (kind == K_S0) {
            LAS float* scr = (LAS float*)(ldsl + wave * 16384);
            constexpr int I_IN = 16 * (INW / 32), I_UQ = 6 * 24, I_UKV = 4 * 32, I_MKV = 16 * 32, I_BR = 8 * 32, I_OUT = 16 * 32;
            constexpr int I_L = I_IN + I_UQ + I_UKV + I_MKV + 3 * I_BR + I_OUT;
            for (int it = gw; it < DEPTH * I_L; it += NGW) {
                const int ll = it / I_L; int r = it % I_L;
                unsigned char* lwl = ws + WS_LW + (size_t)ll * LW_SIZE;
                const float* src; const float* gain = nullptr; bf16_t* dst; int ldn, K, kb, nb, drow;
                if (r < I_IN) { const int nblk = INW / 32; kb = r / nblk; nb = r % nblk; src = p.w_in + (size_t)ll * 1024 * INW; ldn = INW; K = 1024; gain = p.norm_g + ll * 1024; dst = (bf16_t*)(lwl + LW_WIN); drow = win_dst_col(32 * nb); }
                else if ((r -= I_IN) < I_UQ) { kb = r / 24; nb = r % 24; src = p.w_uq + (size_t)ll * 384 * 768; ldn = 768; K = 384; gain = p.q_norm_g + ll * 384; dst = (bf16_t*)(lwl + LW_WUQ); drow = 32 * nb; }
                else if ((r -= I_UQ) < I_UKV) { kb = r / 32; nb = r % 32; src = p.w_ukv + (size_t)ll * 256 * 1024; ldn = 1024; K = 256; gain = p.kv_norm_g + ll * 256; dst = (bf16_t*)(lwl + LW_WUKV); drow = 32 * nb; }
                else if ((r -= I_UKV) < I_MKV) { kb = r / 32; nb = r % 32; src = p.w_mkv + (size_t)ll * 1024 * 1024; ldn = 1024; K = 1024; gain = p.mem_norm_g + ll * 1024; dst = WMKV; drow = ll * 1024 + 32 * nb; }
                else if ((r -= I_MKV) < 3 * I_BR) { const int which = r / I_BR, rr = r % I_BR; kb = rr / 32; nb = rr % 32;
                    src = (which == 0 ? p.w_br_attn : (which == 1 ? p.w_br_conv : p.w_br_mem)) + (size_t)ll * 512 * 1024; ldn = 1024; K = 512; dst = (bf16_t*)(lwl + LW_WBA + (size_t)which * SZ_WBR); drow = 32 * nb; }
                else { r -= 3 * I_BR; kb = r / 32; nb = r % 32; src = p.w_out + (size_t)ll * 1024 * 1024; ldn = 1024; K = 1024; dst = (bf16_t*)(lwl + LW_WOUT); drow = 32 * nb; }
                transpose_item(src, ldn, K, gain, dst, 64 * kb, 32 * nb, drow, scr, lane);
            }
            for (int i = bx * 512 + tid; i < DEPTH * 96 * 128; i += G * 512) { const int ll = i / (96 * 128), r = i % (96 * 128);
                *(u32x4*)(ws + WS_LW + (size_t)ll * LW_SIZE + LW_WIN + (size_t)INW * 2048 + (size_t)r * 16) = (u32x4){0u, 0u, 0u, 0u}; }
            rows_to_bf16(p.mem, MEMB, MRSTD, NB * MEML, gw, NGW, lane);
            rows_to_bf16(p.x, XB, RSTD, SEQ, gw, NGW, lane);
            if (bx == 0 && tid < 16) KQMAX[tid] = 0.f;
        } else if (kind == K_S2) {
            for (int it = gw; it < NB * MEML * DEPTH; it += NGW) { const int m = it & 511, ll = it >> 9, bb = m >> 8, jr = m & 255;
                const bf16_t* src = MKVRAW + (size_t)m * 4096 + ll * 1024;
#pragma unroll
                for (int i = 0; i < 2; ++i) { const int c = lane + 64 * i, head = c >> 5, part = (c >> 4) & 1, d0 = (c & 15) * 8;
                    const u32x4 w = *(const u32x4*)(src + c * 8);
                    float ss = sumsq8(w); ss = sum16(ss);
                    const float rs = rsqrtf(ss * (1.f / 128.f) + EPS);
                    const float* gk = p.mem_k_g + ll * 128 + d0;
                    u32x4 o = w;
                    if (part == 0) { o.x = cvtpk(bflo(w.x) * rs * gk[0], bfhi(w.x) * rs * gk[1]); o.y = cvtpk(bflo(w.y) * rs * gk[2], bfhi(w.y) * rs * gk[3]);
                                     o.z = cvtpk(bflo(w.z) * rs * gk[4], bfhi(w.z) * rs * gk[5]); o.w = cvtpk(bflo(w.w) * rs * gk[6], bfhi(w.w) * rs * gk[7]); }
                    const size_t hb = (size_t)((ll * 2 + bb) * 4 + head) * 256 * 128;
                    bf16_t* dst = (part == 0) ? MK + hb + (size_t)jr * 128 + d0 : MV + hb + (size_t)jr * 128 + d0;
                    *(u32x4*)dst = o; }
            }
        } else if (kind == K_ROWS) {
            rows_to_bf16(xin, XB, RSTD, SEQ, gw, NGW, lane);
            if (bx == 0 && tid < 16) KQMAX[tid] = 0.f;
        } else if (kind == K_CONV) {
            const float* cw = p.conv_w + l * 3 * 512; const float* cbv = p.conv_b + l * 512; const float* mqg = p.mem_q_g + l * 128;
            const int c0 = lane * 8;
            const f32x4 w0a = *(const f32x4*)(cw + c0), w0b = *(const f32x4*)(cw + c0 + 4), w1a = *(const f32x4*)(cw + 512 + c0), w1b = *(const f32x4*)(cw + 512 + c0 + 4);
            const f32x4 w2a = *(const f32x4*)(cw + 1024 + c0), w2b = *(const f32x4*)(cw + 1024 + c0 + 4), bia = *(const f32x4*)(cbv + c0), bib = *(const f32x4*)(cbv + c0 + 4);
            const f32x4 gqa = *(const f32x4*)(mqg + (lane & 15) * 8), gqb = *(const f32x4*)(mqg + (lane & 15) * 8 + 4);
            const float W0[8] = {w0a.x, w0a.y, w0a.z, w0a.w, w0b.x, w0b.y, w0b.z, w0b.w}, W1[8] = {w1a.x, w1a.y, w1a.z, w1a.w, w1b.x, w1b.y, w1b.z, w1b.w};
            const float W2[8] = {w2a.x, w2a.y, w2a.z, w2a.w, w2b.x, w2b.y, w2b.z, w2b.w}, BI[8] = {bia.x, bia.y, bia.z, bia.w, bib.x, bib.y, bib.z, bib.w};
            const float gq[8] = {gqa.x, gqa.y, gqa.z, gqa.w, gqb.x, gqb.y, gqb.z, gqb.w};
            for (int t = gw; t < SEQ; t += NGW) {
                bf16_t* pr = PROJ + (size_t)t * PJ;
                const u32x4 z4 = (u32x4){0u, 0u, 0u, 0u};
                const u32x4 cc0 = *(const u32x4*)(pr + C_CC + c0), cu0 = *(const u32x4*)(pr + C_CU + c0);
                const u32x4 ccm = t > 0 ? *(const u32x4*)(pr - PJ + C_CC + c0) : z4, cum = t > 0 ? *(const u32x4*)(pr - PJ + C_CU + c0) : z4;
                const u32x4 ccp = t < SEQ - 1 ? *(const u32x4*)(pr + PJ + C_CC + c0) : z4, cup = t < SEQ - 1 ? *(const u32x4*)(pr + PJ + C_CU + c0) : z4;
                const u32x4 cb = *(const u32x4*)(pr + C_CB + c0), gc = *(const u32x4*)(pr + C_GCONV + c0);
                const u32x4 qm = *(const u32x4*)(pr + C_QMEM + c0);
                u32x4 oc;
#pragma unroll
                for (int i = 0; i < 4; ++i) {
                    const float lo_ = bflo(cb[i]) * (W0[2 * i] * bflo(ccm[i]) * bflo(cum[i]) + W1[2 * i] * bflo(cc0[i]) * bflo(cu0[i]) + W2[2 * i] * bflo(ccp[i]) * bflo(cup[i]) + BI[2 * i]) * bflo(gc[i]);
                    const float hi_ = bfhi(cb[i]) * (W0[2 * i + 1] * bfhi(ccm[i]) * bfhi(cum[i]) + W1[2 * i + 1] * bfhi(cc0[i]) * bfhi(cu0[i]) + W2[2 * i + 1] * bfhi(ccp[i]) * bfhi(cup[i]) + BI[2 * i + 1]) * bfhi(gc[i]);
                    oc[i] = cvtpk(lo_, hi_);
                }
                *(u32x4*)(pr + C_CB + c0) = oc;
                float ss = sumsq8(qm); ss = sum16(ss);
                const float rs = rsqrtf(ss * (1.f / 128.f) + EPS);
                u32x4 oq; oq.x = cvtpk(bflo(qm.x) * rs * gq[0], bfhi(qm.x) * rs * gq[1]); oq.y = cvtpk(bflo(qm.y) * rs * gq[2], bfhi(qm.y) * rs * gq[3]);
                oq.z = cvtpk(bflo(qm.z) * rs * gq[4], bfhi(qm.z) * rs * gq[5]); oq.w = cvtpk(bflo(qm.w) * rs * gq[6], bfhi(qm.w) * rs * gq[7]);
                *(u32x4*)(pr + C_QMEM + c0) = oq;
            }
        } else if (kind == K_QKV) {
            const float* qg = p.q_head_g + l * 96; const float* kg = p.k_head_g + l * 96;
            const int h = lane >> 3, j = lane & 7;
            const float if0 = p.inv_freq[2 * j], if1 = p.inv_freq[2 * j + 1];
            const f32x4 qga = *(const f32x4*)(qg + 8 * j), qgb = *(const f32x4*)(qg + 8 * j + 4), kga = *(const f32x4*)(kg + 8 * j), kgb = *(const f32x4*)(kg + 8 * j + 4);
            const float QG[8] = {qga.x, qga.y, qga.z, qga.w, qgb.x, qgb.y, qgb.z, qgb.w}, KG[8] = {kga.x, kga.y, kga.z, kga.w, kgb.x, kgb.y, kgb.z, kgb.w};
            const float qr0 = qg[64 + 2 * j], qr1 = qg[65 + 2 * j], qr2 = qg[80 + 2 * j], qr3 = qg[81 + 2 * j];
            const float kr0 = kg[64 + 2 * j], kr1 = kg[65 + 2 * j], kr2 = kg[80 + 2 * j], kr3 = kg[81 + 2 * j];
            constexpr float CQ = 0.10206207261596575f * 1.4426950408889634f;
            float qmax2 = 0.f, kmax2 = 0.f;
            for (int t = gw; t < SEQ; t += NGW) {
                const bf16_t* pr = PROJ + (size_t)t * PJ;
                float sq = 0.f, skv = 0.f;
                if (lane < 48) sq = sumsq8(*(const u32x4*)(pr + C_QLAT + lane * 8));
                if (lane < 32) skv = sumsq8(*(const u32x4*)(pr + C_KVLAT + lane * 8));
                sq = wave_sum(sq); skv = wave_sum(skv);
                const float rq = rsqrtf(sq * (1.f / 384.f) + EPS), rkv = rsqrtf(skv * (1.f / 256.f) + EPS);
                const float pf = (float)p.pos[b * SEQ + t];
                const float a0 = pf * if0, a1 = pf * if1;
                const double r0 = (double)a0 * 0.15915494309189535, r1 = (double)a1 * 0.15915494309189535;
                const float f0 = (float)(r0 - rint(r0)), f1 = (float)(r1 - rint(r1));
                const float c0 = __builtin_amdgcn_cosf(f0), s0 = __builtin_amdgcn_sinf(f0), c1 = __builtin_amdgcn_cosf(f1), s1 = __builtin_amdgcn_sinf(f1);
                {
                    const bf16_t* qp = QRAW + (size_t)t * 768 + h * 96;
                    const u32x4 qn = *(const u32x4*)(qp + 8 * j); const unsigned qa = *(const unsigned*)(qp + 64 + 2 * j), qb = *(const unsigned*)(qp + 80 + 2 * j);
                    float v0 = bflo(qn.x) * rq, v1 = bfhi(qn.x) * rq, v2 = bflo(qn.y) * rq, v3 = bfhi(qn.y) * rq, v4 = bflo(qn.z) * rq, v5 = bfhi(qn.z) * rq, v6 = bflo(qn.w) * rq, v7 = bfhi(qn.w) * rq;
                    float t10 = bflo(qa) * rq, t11 = bfhi(qa) * rq, t20 = bflo(qb) * rq, t21 = bfhi(qb) * rq;
                    float ss = (v0 * v0 + v1 * v1) + (v2 * v2 + v3 * v3) + (v4 * v4 + v5 * v5) + (v6 * v6 + v7 * v7) + (t10 * t10 + t11 * t11) + (t20 * t20 + t21 * t21);
                    ss = sum8(ss);
                    const float rh = rsqrtf(ss * (1.f / 96.f) + EPS);
                    const float rc = rh * CQ;
                    v0 *= rc * QG[0]; v1 *= rc * QG[1]; v2 *= rc * QG[2]; v3 *= rc * QG[3]; v4 *= rc * QG[4]; v5 *= rc * QG[5]; v6 *= rc * QG[6]; v7 *= rc * QG[7];
                    t10 *= rc * qr0; t11 *= rc * qr1; t20 *= rc * qr2; t21 *= rc * qr3;
                    float n2 = (v0 * v0 + v1 * v1) + (v2 * v2 + v3 * v3) + (v4 * v4 + v5 * v5) + (v6 * v6 + v7 * v7) + (t10 * t10 + t11 * t11) + (t20 * t20 + t21 * t21);
                    n2 = sum8(n2);
                    qmax2 = fmaxf(qmax2, n2); if (j == 0) QN[(size_t)t * 8 + h] = sqrtf(n2);
                    u32x4 o; o.x = cvtpk(v0, v1); o.y = cvtpk(v2, v3); o.z = cvtpk(v4, v5); o.w = cvtpk(v6, v7);
                    bf16_t* qo = QF + (size_t)t * 768 + h * 96;
                    *(u32x4*)(qo + 8 * j) = o;
                    *(unsigned*)(qo + 64 + 2 * j) = cvtpk(t10 * c0 - t20 * s0, t11 * c1 - t21 * s1);
                    *(unsigned*)(qo + 80 + 2 * j) = cvtpk(t20 * c0 + t10 * s0, t21 * c1 + t11 * s1);
                }
                {
                    const bf16_t* kp = KVRAW + (size_t)t * 1024 + h * 128;
                    const u32x4 kn = *(const u32x4*)(kp + 8 * j), vv = *(const u32x4*)(kp + 64 + 8 * j);
                    const unsigned ka = *(const unsigned*)(pr + C_KPE + 2 * j), kb = *(const unsigned*)(pr + C_KPE + 16 + 2 * j);
                    float v0 = bflo(kn.x) * rkv, v1 = bfhi(kn.x) * rkv, v2 = bflo(kn.y) * rkv, v3 = bfhi(kn.y) * rkv, v4 = bflo(kn.z) * rkv, v5 = bfhi(kn.z) * rkv, v6 = bflo(kn.w) * rkv, v7 = bfhi(kn.w) * rkv;
                    float t10 = bflo(ka), t11 = bfhi(ka), t20 = bflo(kb), t21 = bfhi(kb);
                    float ss = (v0 * v0 + v1 * v1) + (v2 * v2 + v3 * v3) + (v4 * v4 + v5 * v5) + (v6 * v6 + v7 * v7) + (t10 * t10 + t11 * t11) + (t20 * t20 + t21 * t21);
                    ss = sum8(ss);
                    const float rh = rsqrtf(ss * (1.f / 96.f) + EPS);
                    v0 *= rh * KG[0]; v1 *= rh * KG[1]; v2 *= rh * KG[2]; v3 *= rh * KG[3]; v4 *= rh * KG[4]; v5 *= rh * KG[5]; v6 *= rh * KG[6]; v7 *= rh * KG[7];
                    t10 *= rh * kr0; t11 *= rh * kr1; t20 *= rh * kr2; t21 *= rh * kr3;
                    float n2 = (v0 * v0 + v1 * v1) + (v2 * v2 + v3 * v3) + (v4 * v4 + v5 * v5) + (v6 * v6 + v7 * v7) + (t10 * t10 + t11 * t11) + (t20 * t20 + t21 * t21);
                    n2 = sum8(n2);
                    kmax2 = fmaxf(kmax2, n2);
                    u32x4 o; o.x = cvtpk(v0, v1); o.y = cvtpk(v2, v3); o.z = cvtpk(v4, v5); o.w = cvtpk(v6, v7);
                    bf16_t* ko = KF + ((size_t)h * SEQ + t) * 96;
                    *(u32x4*)(ko + 8 * j) = o;
                    *(unsigned*)(ko + 64 + 2 * j) = cvtpk(t10 * c0 - t20 * s0, t11 * c1 - t21 * s1);
                    *(unsigned*)(ko + 80 + 2 * j) = cvtpk(t20 * c0 + t10 * s0, t21 * c1 + t11 * s1);
                    u32x4 ov; ov.x = cvtpk(bflo(vv.x) * rkv, bfhi(vv.x) * rkv); ov.y = cvtpk(bflo(vv.y) * rkv, bfhi(vv.y) * rkv); ov.z = cvtpk(bflo(vv.z) * rkv, bfhi(vv.z) * rkv); ov.w = cvtpk(bflo(vv.w) * rkv, bfhi(vv.w) * rkv);
                    *(u32x4*)(VF + ((size_t)h * SEQ + t) * 64 + 8 * j) = ov;
                }
            }
            {
                LAS float* red = (LAS float*)ldsl;
                if (j == 0) { red[wave * 16 + h] = qmax2; red[wave * 16 + 8 + h] = kmax2; }
                __syncthreads();
                if (tid < 16) { float mx = 0.f;
#pragma unroll
                    for (int w = 0; w < NWAVES; ++w) mx = fmaxf(mx, red[w * 16 + tid]);
                    atomicMax((unsigned*)KQMAX + tid, __float_as_uint(mx)); }
            }
        } else if (kind == K_MATT) {
#ifndef NO_MATT
            for (int u = bx; u < 4 * (SEQ / 256); u += G) { const int hm = u & 3, qb = u >> 2;
                const size_t kvoff = ((size_t)((l * 2 + b) * 4 + hm) * 256) * 128;
                att::attn_mem<PJ, PJ>(PROJ + (size_t)qb * 256 * PJ + C_QMEM + hm * 128, MK + kvoff, MV + kvoff, PROJ + (size_t)qb * 256 * PJ + C_GMEM + hm * 128, (char*)lds, tid);
            }
#endif
        } else if (kind == K_ATT) {
#ifndef NO_ATT
            { int tf = tid; asm volatile("" : "+v"(tf));
              for (int u = bx; u < NH * (SEQ / 256); u += G) { const int hh = u & 7, qb = u >> 3;
                const float kmx = sqrtf(KQMAX[8 + hh]), qmx = sqrtf(KQMAX[hh]);
                if (qmx * kmx <= 60.f)
                    att::attn_dma4<768, PJ>(QF + (size_t)qb * 256 * 768 + hh * 96, KF + (size_t)hh * SEQ * 96, VF + (size_t)hh * SEQ * 64,
                                       PROJ + (size_t)qb * 256 * PJ + C_GATTN + hh * 64, SEQ, (char*)lds, tf, QN + (size_t)qb * 256 * 8 + hh, kmx);
              } }
            { int ts = tid; asm volatile("" : "+v"(ts));
              for (int u = bx; u < NH * (SEQ / 256); u += G) { const int hh = u & 7, qb = u >> 3;
                const float kmx = sqrtf(KQMAX[8 + hh]), qmx = sqrtf(KQMAX[hh]);
                if (!(qmx * kmx <= 60.f))
                    att::attn_unit<96, 64, 1, 768, PJ, true, false>(QF + (size_t)qb * 256 * 768 + hh * 96, KF + (size_t)hh * SEQ * 96, VF + (size_t)hh * SEQ * 64,
                                       PROJ + (size_t)qb * 256 * PJ + C_GATTN + hh * 64, SEQ, (char*)lds, ts, nullptr, 0.f);
              } }
#endif
        }
#endif
        __syncthreads();
        if (sync_after && st + 1 < hi) { if (lo < 0) grid.sync(); else xcd_barrier(xbar); }
    }
}

extern "C" void kernel_launch(void* const* d_in, const int* in_sizes, int n_in, void* d_out, int out_size, void* d_ws, size_t ws_size, hipStream_t stream) {
    static int grid = 0;
    if (grid == 0) {
        if (n_in != 22 || in_sizes[0] != NB * SEQ * DM || out_size != NB * SEQ * DM || ws_size < WS_END) {
            fprintf(stderr, "kernel_launch: shape/workspace mismatch: n_in %d in0 %d out %d ws %zu (need %zu)\n", n_in, n_in > 0 ? in_sizes[0] : -1, out_size, ws_size, (size_t)WS_END); grid = -1; return; }
        int dev = 0, cus = 0, per_cu = 0;
        if (hipGetDevice(&dev) != hipSuccess || hipDeviceGetAttribute(&cus, hipDeviceAttributeMultiprocessorCount, dev) != hipSuccess) { grid = -1; return; }
        if (hipFuncSetAttribute((const void*)mega, hipFuncAttributeMaxDynamicSharedMemorySize, LDS_BYTES) != hipSuccess) { fprintf(stderr, "kernel_launch: hipFuncSetAttribute failed\n"); grid = -1; return; }
        if (hipOccupancyMaxActiveBlocksPerMultiprocessor(&per_cu, (const void*)mega, NWAVES * 64, LDS_BYTES) != hipSuccess || per_cu < 1) { fprintf(stderr, "kernel_launch: occupancy query gave %d\n", per_cu); per_cu = 1; }
        (void)hipGetLastError();
        grid = cus * 1;
    }
    if (grid < 0) return;
    Params p{};
    p.x = (const float*)d_in[0]; p.mem = (const float*)d_in[1]; p.pos = (const int*)d_in[2];
    p.norm_g = (const float*)d_in[3]; p.w_in = (const float*)d_in[4]; p.b_gate = (const float*)d_in[5]; p.q_norm_g = (const float*)d_in[6]; p.w_uq = (const float*)d_in[7];
    p.kv_norm_g = (const float*)d_in[8]; p.w_ukv = (const float*)d_in[9]; p.q_head_g = (const float*)d_in[10]; p.k_head_g = (const float*)d_in[11]; p.conv_w = (const float*)d_in[12];
    p.conv_b = (const float*)d_in[13]; p.mem_norm_g = (const float*)d_in[14]; p.w_mkv = (const float*)d_in[15]; p.mem_q_g = (const float*)d_in[16]; p.mem_k_g = (const float*)d_in[17];
    p.w_br_attn = (const float*)d_in[18]; p.w_br_conv = (const float*)d_in[19]; p.w_br_mem = (const float*)d_in[20]; p.w_out = (const float*)d_in[21];
    p.out = (float*)d_out; p.ws = (unsigned char*)d_ws;
    for (int i = 0; i < 16; ++i) p.inv_freq[i] = (float)pow(10000.0, -(double)i / 16.0);
    if (hipMemsetAsync((char*)d_ws + WS_BAR, 0, 16384, stream) != hipSuccess) { fprintf(stderr, "kernel_launch: memset failed\n"); return; }
#if MK_MULTI
    for (int st = 0; st < N_STEPS;) { int e = st;
        for (;;) { const bool sy = (e < 3) ? true : step_sync((e - 3) % STEPS_PER); ++e; if (sy || e >= N_STEPS) break; }
        hipLaunchKernelGGL(mega, dim3(grid), dim3(NWAVES * 64), LDS_BYTES, stream, p, st, e); st = e; }
#else
    int lo = 0, hi = N_STEPS;
    void* args[] = {&p, &lo, &hi};
    const hipError_t e = hipLaunchCooperativeKernel((const void*)mega, dim3(grid), dim3(NWAVES * 64), args, LDS_BYTES, stream);
    if (e != hipSuccess) fprintf(stderr, "kernel_launch: cooperative launch failed: %s (grid %d)\n", hipGetErrorString(e), grid);
#endif
}
```

```cpp
#include <hip/hip_runtime.h>
#include <hip/hip_cooperative_groups.h>
#include <cstdio>
#include <cstdint>
#include <cmath>
namespace cg = cooperative_groups;

#ifndef EN_MASK
#define EN_MASK 0xFFFF
#endif
#define EN(i) ((EN_MASK >> (i)) & 1)
#ifndef MK_MULTI
#define MK_MULTI 0
#endif

constexpr int DM = 1024, NB = 2, SEQ = 16384, DEPTH = 4, MEML = 256;
constexpr int NH = 8, QLR = 384, KVLR = 256;
constexpr int INW = 7328, PJ = 7424;
constexpr float EPS = 1e-6f;
constexpr int LDS_SCR_OFF = 132224;
constexpr int C_RATTN = 0, C_RCONV = 1024, C_RMEM = 2048, C_GATTN = 3072, C_GCONV = 3584, C_GMEM = 4096, C_CB = 4608, C_CC = 5120, C_CU = 5632,
              C_QMEM = 6144, C_KVLAT = 6656, C_QLAT = 6912, C_KPE = 7296;
constexpr size_t MiB = 1u << 20;
constexpr size_t SZ_WIN = (size_t)PJ * 1024 * 2, SZ_WUQ = 768 * 384 * 2, SZ_WUKV = 1024 * 256 * 2, SZ_WBR = 1024 * 512 * 2, SZ_WOUT = 1024 * 1024 * 2;
constexpr size_t LW_WIN = 0, LW_WUQ = LW_WIN + SZ_WIN, LW_WUKV = LW_WUQ + SZ_WUQ, LW_WBA = LW_WUKV + SZ_WUKV, LW_WBC = LW_WBA + SZ_WBR, LW_WBM = LW_WBC + SZ_WBR,
                 LW_WOUT = LW_WBM + SZ_WBR, LW_SIZE = LW_WOUT + SZ_WOUT;
constexpr size_t WS_LW = 0;
constexpr size_t WS_WMKV = ((WS_LW + 4 * LW_SIZE + 4095) / 4096) * 4096;
constexpr size_t WS_MEMB = WS_WMKV + 8 * MiB;
constexpr size_t WS_MKVRAW = WS_MEMB + 1 * MiB;
constexpr size_t WS_MK = WS_MKVRAW + 4 * MiB;
constexpr size_t WS_MV = WS_MK + 2 * MiB;
constexpr size_t WS_MRSTD = WS_MV + 2 * MiB;
constexpr size_t WS_RSTD = WS_MRSTD + 4096;
constexpr size_t WS_XB = WS_RSTD + 65536;
constexpr size_t WS_PROJ = WS_XB + 32 * MiB;
constexpr size_t WS_QRAW = WS_PROJ + (size_t)SEQ * PJ * 2;
constexpr size_t WS_KVRAW = WS_QRAW + 24 * MiB;
constexpr size_t WS_QF = WS_KVRAW + 32 * MiB;
constexpr size_t WS_KF = WS_QF + 24 * MiB;
constexpr size_t WS_VF = WS_KF + 24 * MiB;
constexpr size_t WS_BAR = WS_VF + 16 * MiB;
constexpr size_t WS_QN = WS_BAR + 16384;
constexpr size_t WS_KQMAX = WS_QN + (size_t)SEQ * 8 * 4;
constexpr size_t WS_END = WS_KQMAX + 256;

typedef unsigned short bf16_t;
typedef short bf16x8 __attribute__((ext_vector_type(8)));
typedef short s16x4 __attribute__((ext_vector_type(4)));
typedef float f32x4 __attribute__((ext_vector_type(4)));
typedef float f32x16 __attribute__((ext_vector_type(16)));
typedef unsigned u32x4 __attribute__((ext_vector_type(4)));
typedef unsigned u32x2 __attribute__((ext_vector_type(2)));
#define LAS __attribute__((address_space(3)))

__device__ __forceinline__ unsigned cvtpk(float lo, float hi) { unsigned r; asm volatile("v_cvt_pk_bf16_f32 %0, %1, %2" : "=v"(r) : "v"(lo), "v"(hi)); return r; }
__device__ __forceinline__ float bflo(unsigned w) { return __uint_as_float(w << 16); }
__device__ __forceinline__ float bfhi(unsigned w) { return __uint_as_float(w & 0xffff0000u); }
__device__ __forceinline__ float bf1(bf16_t h) { return __uint_as_float(((unsigned)h) << 16); }
__device__ __forceinline__ float sigmoidf_(float v) { return __builtin_amdgcn_rcpf(1.f + __builtin_amdgcn_exp2f(-1.4426950408889634f * v)); }
template <int CTRL> __device__ __forceinline__ float dpp_mov(float v) { return __uint_as_float((unsigned)__builtin_amdgcn_update_dpp(0, (int)__float_as_uint(v), CTRL, 0xF, 0xF, true)); }
__device__ __forceinline__ float sum8(float v) { v += dpp_mov<0xB1>(v); v += dpp_mov<0x4E>(v); v += dpp_mov<0x141>(v); return v; }
__device__ __forceinline__ float sum16(float v) { v = sum8(v); v += dpp_mov<0x140>(v); return v; }
__device__ __forceinline__ float wave_sum(float v) {
    v = sum16(v);
    const float a = __uint_as_float((unsigned)__builtin_amdgcn_readlane((int)__float_as_uint(v), 0)), b = __uint_as_float((unsigned)__builtin_amdgcn_readlane((int)__float_as_uint(v), 16));
    const float c = __uint_as_float((unsigned)__builtin_amdgcn_readlane((int)__float_as_uint(v), 32)), d = __uint_as_float((unsigned)__builtin_amdgcn_readlane((int)__float_as_uint(v), 48));
    return (a + b) + (c + d);
}
__device__ __forceinline__ float sumsq8(u32x4 w) {
    float s = 0.f;
#pragma unroll
    for (int i = 0; i < 4; ++i) { const float a = bflo(w[i]), b = bfhi(w[i]); s += a * a + b * b; }
    return s;
}

namespace pg8 {
constexpr int BM = 256, BK = 64, HALF = 128, HTB = HALF * BK * 2, STAGE_BYTES = 8 * HTB, NXCD = 8, WGM = 4;
__host__ __device__ __forceinline__ int lds_byte(int r, int c) { const int st = (r >> 4) * 2 + (c >> 5), rr = r & 15, cc = c & 31, ob = rr * 64 + cc * 2; return st * 1024 + (ob ^ (((ob >> 9) & 1) << 5)); }
__host__ __device__ __forceinline__ void stage_rc(int b, int& R, int& C) { const int st = b / 1024, sb = b % 1024, swz = sb ^ (((sb >> 9) & 1) << 5); R = (st >> 1) * 16 + swz / 64; C = (st & 1) * 32 + (swz % 64) / 2; }
__host__ __device__ __forceinline__ int perm32(int rho) { const int n = rho >> 4, i = rho & 15; return 8 * (i >> 2) + 4 * n + (i & 3); }
struct Unit { int pm, pn; };
struct Gemm { const bf16_t* A; const bf16_t* Bt; int M, N, K, lda; };
struct StaticOrder {
    int nM, nN, nwg, G, c;
    __device__ void init(int M, int N, int G_, int c_) { nM = M / BM; nN = N / BM; nwg = nM * nN; G = G_; c = c_; }
    __device__ bool next(int i, Unit& u) const {
        const long L = (long)i * G + c; if (L >= nwg) return false;
        int wgid = (int)L; { const int q = nwg / NXCD, r = nwg % NXCD, xcd = wgid % NXCD, off = wgid / NXCD; wgid = (xcd < r ? xcd * (q + 1) : r * (q + 1) + (xcd - r) * q) + off; }
        const int nig = WGM * nN, gid = wgid / nig, fm = gid * WGM, gsz = (nM - fm) < WGM ? (nM - fm) : WGM;
        u.pm = fm + ((wgid % nig) % gsz); u.pn = (wgid % nig) / gsz; return true;
    }
};
struct EpiRT {
    static constexpr bool PERM = true;
    int mode; bf16_t* O; int ldc; const float* rstd; const float* bias; const bf16_t* R; const float* Xin; float* Xout; int ldr;
    __device__ __forceinline__ void operator()(const f32x4 (&acc)[2][2][4][2], const Unit& u, int wr, int wc, int fr, int fq) const {
        const int row0 = u.pm * BM + wr * 64 + fr, col0 = u.pn * BM + wc * 32 + 8 * fq;
        const int kind = (mode == 1) ? (u.pn < 12 ? 0 : (u.pn < 18 ? 1 : 2)) : 2;
        f32x4 bv[2][2];
#pragma unroll
        for (int bj = 0; bj < 2; ++bj) { bv[bj][0] = (f32x4){0.f, 0.f, 0.f, 0.f}; bv[bj][1] = bv[bj][0];
            if (kind == 0) { bv[bj][0] = *(const f32x4*)(bias + col0 + bj * HALF); bv[bj][1] = *(const f32x4*)(bias + col0 + bj * HALF + 4); } }
#pragma unroll
        for (int ai = 0; ai < 2; ++ai)
#pragma unroll
            for (int mp = 0; mp < 2; ++mp) {
                float rs[2]; u32x4 t0[2][2], t1[2][2];
#pragma unroll
                for (int mm = 0; mm < 2; ++mm) { const int row = row0 + ai * HALF + (2 * mp + mm) * 16;
                    rs[mm] = rstd ? rstd[row] : 1.f;
#pragma unroll
                    for (int bj = 0; bj < 2; ++bj) {
                        if (mode == 4) { const size_t off = (size_t)row * 1024 + col0 + bj * HALF; t0[mm][bj] = *(const u32x4*)(Xin + off); t1[mm][bj] = *(const u32x4*)(Xin + off + 4); }
                        else if (mode >= 2) { t0[mm][bj] = *(const u32x4*)(R + (size_t)row * ldr + col0 + bj * HALF);
                            if (mode == 3) t1[mm][bj] = *(const u32x4*)(O + (size_t)row * ldc + col0 + bj * HALF); } } }
#pragma unroll
                for (int mm = 0; mm < 2; ++mm) { const int m = 2 * mp + mm; const int row = row0 + ai * HALF + m * 16;
#pragma unroll
                    for (int bj = 0; bj < 2; ++bj) {
                        f32x4 v0 = acc[ai][bj][m][0], v1 = acc[ai][bj][m][1];
                        if (mode == 4) {
                            const size_t off = (size_t)row * 1024 + col0 + bj * HALF;
                            const u32x4 qa = t0[mm][bj], qb = t1[mm][bj];
                            *(f32x4*)(Xout + off) = (f32x4){__uint_as_float(qa.x), __uint_as_float(qa.y), __uint_as_float(qa.z), __uint_as_float(qa.w)} + v0;
                            *(f32x4*)(Xout + off + 4) = (f32x4){__uint_as_float(qb.x), __uint_as_float(qb.y), __uint_as_float(qb.z), __uint_as_float(qb.w)} + v1;
                        } else {
                            v0 = v0 * rs[mm]; v1 = v1 * rs[mm];
                            if (kind == 0) {
                                v0 = v0 + bv[bj][0]; v1 = v1 + bv[bj][1];
#pragma unroll
                                for (int e = 0; e < 4; ++e) { v0[e] = sigmoidf_(v0[e]); v1[e] = sigmoidf_(v1[e]); }
                            } else if (kind == 1) {
#pragma unroll
                                for (int e = 0; e < 4; ++e) { v0[e] = v0[e] * sigmoidf_(v0[e]); v1[e] = v1[e] * sigmoidf_(v1[e]); }
                            }
                            bf16_t* op = O + (size_t)row * ldc + col0 + bj * HALF;
                            if (mode == 2 || mode == 3) { const u32x4 q = t0[mm][bj];
                                v0[0] *= bflo(q[0]); v0[1] *= bfhi(q[0]); v0[2] *= bflo(q[1]); v0[3] *= bfhi(q[1]);
                                v1[0] *= bflo(q[2]); v1[1] *= bfhi(q[2]); v1[2] *= bflo(q[3]); v1[3] *= bfhi(q[3]);
                                if (mode == 3) { const u32x4 y = t1[mm][bj];
                                    v0[0] += bflo(y[0]); v0[1] += bfhi(y[0]); v0[2] += bflo(y[1]); v0[3] += bfhi(y[1]);
                                    v1[0] += bflo(y[2]); v1[1] += bfhi(y[2]); v1[2] += bflo(y[3]); v1[3] += bfhi(y[3]); } }
                            u32x4 w; w.x = cvtpk(v0[0], v0[1]); w.y = cvtpk(v0[2], v0[3]); w.z = cvtpk(v1[0], v1[1]); w.w = cvtpk(v1[2], v1[3]);
                            *(u32x4*)op = w;
                        }
                    } }
                asm volatile("" ::: "memory");
            }
    }
};

template <class EpiT>
__device__ __forceinline__ void gemm_phase(LAS unsigned char* lds, const Gemm g, const StaticOrder& S, const EpiT& E, const int tid) {
    const int wid = __builtin_amdgcn_readfirstlane(tid >> 6), lane = tid & 63, wr = wid >> 2, wc = wid & 3, fr = lane & 15, fq = lane >> 4;
    const int K = g.K, nt = K / BK;
    unsigned voffA[2], voffB[2];
#pragma unroll
    for (int i = 0; i < 2; ++i) { int R, C; stage_rc(tid * 16 + i * 8192, R, C); const int Rb = EpiT::PERM ? ((R & ~31) + perm32(R & 31)) : R;
        voffA[i] = (unsigned)(R * g.lda + C) * 2u; voffB[i] = (unsigned)(Rb * K + C) * 2u; }
    const size_t kstep = (size_t)(BK * 2);
    const size_t hstepA = (size_t)HALF * g.lda * 2, hstepB = (size_t)HALF * K * 2;
    const size_t tstepA = 2 * hstepA, tstepB = 2 * hstepB;
    const unsigned ldsw = (unsigned)wid * 1024u;
    const int aoff = lds_byte(wr * 64 + fr, fq * 8), boff = lds_byte(wc * 32 + fr, fq * 8);
#define PG8_SA(b, h) (((b) * 2 + (h)) * HTB)
#define PG8_SB(b, h) ((4 + (b) * 2 + (h)) * HTB)
#define PG8_STAGE(bufoff, gbase, voff) do { _Pragma("unroll") for (int _i = 0; _i < 2; ++_i) \
        __builtin_amdgcn_global_load_lds((const unsigned*)((const char*)(gbase) + (voff)[_i]), (LAS unsigned*)(lds + (bufoff) + ldsw + _i * 8192), 16, 0, 0); } while (0)
#define PG8_LDA(dst, b, h) do { _Pragma("unroll") for (int m = 0; m < 4; ++m) _Pragma("unroll") for (int k = 0; k < 2; ++k) dst[m][k] = *(const LAS bf16x8*)(lds + PG8_SA(b, h) + aoff + m * 2048 + k * 1024); } while (0)
#define PG8_LDB(dst, b, h) do { _Pragma("unroll") for (int n = 0; n < 2; ++n) _Pragma("unroll") for (int k = 0; k < 2; ++k) dst[n][k] = *(const LAS bf16x8*)(lds + PG8_SB(b, h) + boff + n * 2048 + k * 1024); } while (0)
#define PG8_MMA(ai, bj, At, Bt) do { __builtin_amdgcn_s_setprio(1); _Pragma("unroll") for (int m = 0; m < 4; ++m) _Pragma("unroll") for (int n = 0; n < 2; ++n) _Pragma("unroll") for (int k = 0; k < 2; ++k) \
        acc[ai][bj][m][n] = __builtin_amdgcn_mfma_f32_16x16x32_bf16(Bt[n][k], At[m][k], acc[ai][bj][m][n], 0, 0, 0); __builtin_amdgcn_s_setprio(0); } while (0)
#define PG8_WAIT_V(n) asm volatile("s_waitcnt vmcnt(" #n ")" ::: "memory")
#define PG8_WAIT_L(n) asm volatile("s_waitcnt lgkmcnt(" #n ")" ::: "memory")
#define PG8_BAR __builtin_amdgcn_s_barrier()
#define PG8_SCHED __builtin_amdgcn_sched_barrier(0)
    Unit cur, nxt; int ui = 0;
    if (!S.next(0, cur)) return;
    f32x4 acc[2][2][4][2];
#pragma unroll
    for (int a = 0; a < 2; ++a)
#pragma unroll
        for (int b = 0; b < 2; ++b)
#pragma unroll
            for (int m = 0; m < 4; ++m)
#pragma unroll
                for (int n = 0; n < 2; ++n) acc[a][b][m][n] = (f32x4){0.f, 0.f, 0.f, 0.f};
    bf16x8 At[4][2], B0[2][2], B1[2][2];
    const char* cA = (const char*)g.A + (size_t)cur.pm * tstepA; const char* cB = (const char*)g.Bt + (size_t)cur.pn * tstepB;
    PG8_STAGE(PG8_SB(0, 0), cB, voffB); PG8_STAGE(PG8_SB(0, 1), cB + hstepB, voffB); PG8_STAGE(PG8_SA(0, 0), cA, voffA); PG8_STAGE(PG8_SA(0, 1), cA + hstepA, voffA);
    if (wr == 1) PG8_BAR;
    PG8_WAIT_V(2); PG8_BAR;
    PG8_STAGE(PG8_SB(1, 0), cB + kstep, voffB); PG8_STAGE(PG8_SA(1, 0), cA + kstep, voffA); PG8_STAGE(PG8_SB(1, 1), cB + hstepB + kstep, voffB);
    PG8_WAIT_V(6); PG8_BAR;
    for (;;) {
        const bool has_next = S.next(ui + 1, nxt);
        const char* nA = has_next ? (const char*)g.A + (size_t)nxt.pm * tstepA : cA; const char* nB = has_next ? (const char*)g.Bt + (size_t)nxt.pn * tstepB : cB;
        for (int t = 0; t < nt; t += 2) {
            const bool last = (t == nt - 2);
            const char* a1 = cA + (size_t)(t + 1) * kstep;
            const char* a2 = last ? nA : cA + (size_t)(t + 2) * kstep; const char* b2 = last ? nB : cB + (size_t)(t + 2) * kstep;
            const char* a3 = a2 + kstep; const char* b3 = b2 + kstep;
            PG8_LDB(B0, 0, 0); PG8_LDB(B1, 0, 1); PG8_SCHED; PG8_LDA(At, 0, 0); PG8_STAGE(PG8_SA(1, 1), a1 + hstepA, voffA);
            PG8_WAIT_V(8); PG8_WAIT_L(0); PG8_BAR; PG8_MMA(0, 0, At, B0); PG8_MMA(0, 1, At, B1); PG8_BAR; PG8_SCHED;
            PG8_LDA(At, 0, 1); PG8_STAGE(PG8_SB(0, 0), b2, voffB); PG8_STAGE(PG8_SB(0, 1), b2 + hstepB, voffB); PG8_STAGE(PG8_SA(0, 0), a2, voffA);
            PG8_WAIT_V(8); PG8_WAIT_L(0); PG8_BAR; PG8_MMA(1, 0, At, B0); PG8_MMA(1, 1, At, B1); PG8_BAR; PG8_SCHED;
            PG8_LDB(B0, 1, 0); PG8_LDB(B1, 1, 1); PG8_SCHED; PG8_LDA(At, 1, 0); PG8_STAGE(PG8_SA(0, 1), a2 + hstepA, voffA);
            PG8_WAIT_V(8); PG8_WAIT_L(0); PG8_BAR; PG8_MMA(0, 0, At, B0); PG8_MMA(0, 1, At, B1); PG8_BAR; PG8_SCHED;
            PG8_LDA(At, 1, 1); PG8_STAGE(PG8_SB(1, 0), b3, voffB); PG8_STAGE(PG8_SB(1, 1), b3 + hstepB, voffB); PG8_STAGE(PG8_SA(1, 0), a3, voffA);
            PG8_WAIT_V(8); PG8_WAIT_L(0); PG8_BAR; PG8_MMA(1, 0, At, B0); PG8_MMA(1, 1, At, B1); PG8_BAR; PG8_SCHED;
        }
        if (wr == 0) PG8_BAR;
        E(acc, cur, wr, wc, fr, fq);
        if (!has_next) break;
#pragma unroll
        for (int a = 0; a < 2; ++a)
#pragma unroll
            for (int b = 0; b < 2; ++b)
#pragma unroll
                for (int m = 0; m < 4; ++m)
#pragma unroll
                    for (int n = 0; n < 2; ++n) acc[a][b][m][n] = (f32x4){0.f, 0.f, 0.f, 0.f};
        cur = nxt; cA = nA; cB = nB; ++ui;
        if (wr == 1) PG8_BAR;
    }
    PG8_WAIT_V(0);
    PG8_BAR;
#undef PG8_SA
#undef PG8_SB
#undef PG8_STAGE
#undef PG8_LDA
#undef PG8_LDB
#undef PG8_MMA
#undef PG8_WAIT_V
#undef PG8_WAIT_L
#undef PG8_BAR
#undef PG8_SCHED
}
}

namespace att {
constexpr int NW = 8, QBLK = 32, KVBLK = 64;
constexpr float THR = 8.f;
constexpr int SHM_K = KVBLK * 256;
#define KSWZ(row, colB) ((row) * 256 + ((colB) ^ ((((row) & 7) | ((((row) >> 4) & 1) << 3)) << 4)))
#define SBAR() __builtin_amdgcn_sched_barrier(0)
__device__ __forceinline__ int crow(int r, int hi) { return (r & 3) + 8 * (r >> 2) + 4 * hi; }
template <int DQ> struct Sc { static constexpr float SCALE = (DQ == 96) ? 0.10206207261596575f : 0.08838834764831845f; };

template <int DQ, bool PRE>
__device__ __forceinline__ void partialSM(f32x16& p0, f32x16& p1, float& m_reg, float& mn, float& alpha) {
    constexpr float SCALE = PRE ? 0.6931471805599453f : Sc<DQ>::SCALE, C = SCALE * 1.4426950408889634f;
    float pmax = p0[0];
#pragma unroll
    for (int r = 1; r < 16; ++r) pmax = fmaxf(pmax, p0[r]);
#pragma unroll
    for (int r = 0; r < 16; ++r) pmax = fmaxf(pmax, p1[r]);
    { auto rr = __builtin_amdgcn_permlane32_swap(__float_as_uint(pmax), __float_as_uint(pmax), false, false);
      pmax = fmaxf(__uint_as_float(rr[0]), __uint_as_float(rr[1])); }
    if (__builtin_expect(__all(pmax - m_reg <= THR / SCALE), 1)) { mn = m_reg; alpha = 1.f; }
    else { mn = fmaxf(m_reg, pmax); alpha = __builtin_amdgcn_exp2f((m_reg - mn) * C); m_reg = mn; }
    const float mnC = -mn * C;
#pragma unroll
    for (int r = 0; r < 16; ++r) p0[r] = fmaf(p0[r], C, mnC);
#pragma unroll
    for (int r = 0; r < 16; ++r) p1[r] = fmaf(p1[r], C, mnC);
#pragma unroll
    for (int r = 0; r < 16; ++r) p0[r] = __builtin_amdgcn_exp2f(p0[r]);
}
__device__ __forceinline__ void finishSM(f32x16& p0, f32x16& p1, float alpha, float& l_reg, bf16x8& pa0, bf16x8& pa1, bf16x8& pa2, bf16x8& pa3) {
#pragma unroll
    for (int r = 0; r < 16; ++r) p1[r] = __builtin_amdgcn_exp2f(p1[r]);
    float ps = 0;
#pragma unroll
    for (int r = 0; r < 16; ++r) ps += p0[r];
#pragma unroll
    for (int r = 0; r < 16; ++r) ps += p1[r];
    { auto rr = __builtin_amdgcn_permlane32_swap(__float_as_uint(ps), __float_as_uint(ps), false, false);
      ps = __uint_as_float(rr[0]) + __uint_as_float(rr[1]); }
    l_reg = l_reg * alpha + ps;
#define PK4(P, BASE, OUT) do { unsigned a0 = cvtpk(P[BASE + 0], P[BASE + 1]), a1 = cvtpk(P[BASE + 2], P[BASE + 3]);   \
    unsigned b0 = cvtpk(P[BASE + 4], P[BASE + 5]), b1 = cvtpk(P[BASE + 6], P[BASE + 7]);                              \
    auto r0 = __builtin_amdgcn_permlane32_swap(a0, b0, false, false); auto r1 = __builtin_amdgcn_permlane32_swap(a1, b1, false, false); \
    u32x4 w = {r0[0], r1[0], r0[1], r1[1]}; OUT = *reinterpret_cast<bf16x8*>(&w); } while (0)
    PK4(p0, 0, pa0); PK4(p0, 8, pa1); PK4(p1, 0, pa2); PK4(p1, 8, pa3);
#undef PK4
}
__device__ __forceinline__ void fastSM0(f32x16& p0) {
#pragma unroll
    for (int r = 0; r < 16; ++r) p0[r] = __builtin_amdgcn_exp2f(p0[r]);
}
template <int DQ>
__device__ __forceinline__ void qkt(f32x16& p0, f32x16& p1, const char* Ks, const bf16x8* qr, int r32, int hi, float init) {
#pragma unroll
    for (int r = 0; r < 16; ++r) { p0[r] = init; p1[r] = init; }
#pragma unroll
    for (int d0 = 0; d0 < DQ / 16; ++d0) { const int cb = (d0 * 16 + hi * 8) * 2;
        const bf16x8 b0 = *reinterpret_cast<const bf16x8*>(Ks + KSWZ(r32, cb));
        const bf16x8 b1 = *reinterpret_cast<const bf16x8*>(Ks + KSWZ(32 + r32, cb));
        p0 = __builtin_amdgcn_mfma_f32_32x32x16_bf16(b0, qr[d0], p0, 0, 0, 0);
        p1 = __builtin_amdgcn_mfma_f32_32x32x16_bf16(b1, qr[d0], p1, 0, 0, 0);
        if (DQ == 128 && d0 == 3) SBAR(); }
}
template <int DV> __device__ __forceinline__ int v_st(int k, int c) { const int kk = (k & ~0xC) | ((k & 4) << 1) | ((k & 8) >> 1); return ((kk >> 3) * (DV / 32) + (c >> 5)) * 512 + ((kk & 7) * 32 + (c & 31)) * 2; }
__device__ __forceinline__ int v_rd_base(int lane) { return ((lane & 3) << 3) | (((lane >> 2) & 3) << 6) | (((lane >> 4) & 1) << 5) | (((lane >> 5) & 1) << 8); }
template <int DV> constexpr int v_rd_off(int d0, int ks, int half) { return d0 * 512 + ks * (4096 * DV / 128) + half * (2048 * DV / 128); }
template <int OFF> __device__ __forceinline__ s16x4 tr_read(int vb) {
    s16x4 r; asm volatile("ds_read_b64_tr_b16 %0, %1 offset:%2" : "=&v"(r) : "v"(vb), "i"(OFF) : "memory"); return r;
}
template <int DV, int D0> __device__ __forceinline__ void pv_one(f32x16& od, int vb, bf16x8 pa0, bf16x8 pa1, bf16x8 pa2, bf16x8 pa3) {
    const s16x4 l0 = tr_read<v_rd_off<DV>(D0, 0, 0)>(vb), h0 = tr_read<v_rd_off<DV>(D0, 0, 1)>(vb), l1 = tr_read<v_rd_off<DV>(D0, 1, 0)>(vb), h1 = tr_read<v_rd_off<DV>(D0, 1, 1)>(vb);
    const s16x4 l2 = tr_read<v_rd_off<DV>(D0, 2, 0)>(vb), h2 = tr_read<v_rd_off<DV>(D0, 2, 1)>(vb), l3 = tr_read<v_rd_off<DV>(D0, 3, 0)>(vb), h3 = tr_read<v_rd_off<DV>(D0, 3, 1)>(vb);
    asm volatile("s_waitcnt lgkmcnt(0)" ::: "memory"); SBAR();
#define PK(L, H) (bf16x8){L[0], L[1], L[2], L[3], H[0], H[1], H[2], H[3]}
    od = __builtin_amdgcn_mfma_f32_32x32x16_bf16(pa0, PK(l0, h0), od, 0, 0, 0);
    od = __builtin_amdgcn_mfma_f32_32x32x16_bf16(pa1, PK(l1, h1), od, 0, 0, 0);
    od = __builtin_amdgcn_mfma_f32_32x32x16_bf16(pa2, PK(l2, h2), od, 0, 0, 0);
    od = __builtin_amdgcn_mfma_f32_32x32x16_bf16(pa3, PK(l3, h3), od, 0, 0, 0);
#undef PK
}
template <int DV> __device__ __forceinline__ void pv_all(f32x16* o, int vb, bf16x8 pa0, bf16x8 pa1, bf16x8 pa2, bf16x8 pa3) {
    pv_one<DV, 0>(o[0], vb, pa0, pa1, pa2, pa3); pv_one<DV, 1>(o[1], vb, pa0, pa1, pa2, pa3);
    if constexpr (DV == 128) { pv_one<DV, 2>(o[2], vb, pa0, pa1, pa2, pa3); pv_one<DV, 3>(o[3], vb, pa0, pa1, pa2, pa3); }
}

template <int DQ, int DV, int SD, int ldq, int ldo, bool PRE, bool FAST>
__device__ __forceinline__ void attn_unit(const bf16_t* Qb, const bf16_t* Kh, const bf16_t* Vh, bf16_t* OG, int seq, char* lds, const int tid, const float* qn, float kmax) {
    constexpr int NQ = DQ / 16, NO = DV / 32, SHM_V = KVBLK * DV * 2;
    constexpr int KCH = DQ / 8, VCH = DV / 8;
    constexpr int NVI = KVBLK * VCH / 512;
    constexpr bool K2ALL = (KVBLK * KCH == 1024);
    const int wid = tid >> 6, lane = tid & 63, r32 = lane & 31, hi = lane >> 5;
    char* V_lds = lds; char* K_lds = lds + 2 * SHM_V;
    float* wsf = (float*)(lds + 2 * SHM_V + 2 * SHM_K) + wid * 64; float* li_l = wsf; float* al_l = wsf + 32;
    float m_reg = -1e30f, l_reg = 0; f32x16 o[NO]; bf16x8 qr[NQ];
    float negm = 0.f; if constexpr (FAST) negm = -(qn[(wid * QBLK + r32) * 8] * kmax);
#pragma unroll
    for (int d = 0; d < NO; ++d) o[d] = f32x16{};
    const bf16_t* Qw = Qb + (size_t)(wid * QBLK + r32) * ldq + hi * 8;
#pragma unroll
    for (int d0 = 0; d0 < NQ; ++d0) qr[d0] = *reinterpret_cast<const bf16x8*>(Qw + d0 * 16);
    const int kc0 = tid, kc1 = tid + 512;
    const int kl0 = KSWZ(kc0 / KCH, (kc0 % KCH) * 16), kl1 = KSWZ(kc1 / KCH, (kc1 % KCH) * 16);
    const bool k1on = K2ALL || (wid < 4);
    const int vl0 = v_st<DV>(tid / VCH, (tid % VCH) * 8), vl1 = v_st<DV>((tid + 512) / VCH, ((tid + 512) % VCH) * 8);
    const int vb0 = (int)(uintptr_t)V_lds + v_rd_base(lane);
    struct Slot { bf16x8 v0, v1, k0, k1; }; Slot sA, sB2; Slot& sB = (SD == 2) ? sB2 : sA;
#define SLOAD(S, key0) do { const bf16_t* kp_ = Kh + (size_t)(key0) * DQ; const bf16_t* vp_ = Vh + (size_t)(key0) * DV; \
        S.v0 = *reinterpret_cast<const bf16x8*>(vp_ + tid * 8); if constexpr (NVI == 2) S.v1 = *reinterpret_cast<const bf16x8*>(vp_ + (tid + 512) * 8); \
        S.k0 = *reinterpret_cast<const bf16x8*>(kp_ + kc0 * 8); if (k1on) S.k1 = *reinterpret_cast<const bf16x8*>(kp_ + kc1 * 8); } while (0)
#define SWRITE(b, S) do { *(bf16x8*)(V_lds + (b) * SHM_V + vl0) = S.v0; if constexpr (NVI == 2) *(bf16x8*)(V_lds + (b) * SHM_V + vl1) = S.v1; \
        *(bf16x8*)(K_lds + (b) * SHM_K + kl0) = S.k0; if (k1on) *(bf16x8*)(K_lds + (b) * SHM_K + kl1) = S.k1; } while (0)
#define RESC(a) do { if (__any((a) < 1.f)) { if (hi == 0) al_l[r32] = (a); asm volatile("s_waitcnt lgkmcnt(0)" ::: "memory"); \
        _Pragma("unroll") for (int d = 0; d < NO; ++d) _Pragma("unroll") for (int r = 0; r < 16; ++r) o[d][r] *= al_l[crow(r, hi)]; } } while (0)
    f32x16 pA0, pA1, pB0, pB1; float mnA, mnB, alA, alB; bf16x8 pa0, pa1, pa2, pa3; const int NT = seq / KVBLK;
    SLOAD(sA, 0); SWRITE(0, sA); __syncthreads();
#define PSM(P0, P1, MN, AL) do { if constexpr (FAST) { fastSM0(P0); AL = 1.f; } else partialSM<DQ, PRE>(P0, P1, m_reg, MN, AL); } while (0)
#define RESCX(a) do { if constexpr (!FAST) RESC(a); } while (0)
    qkt<DQ>(pA0, pA1, K_lds, qr, r32, hi, negm); PSM(pA0, pA1, mnA, alA);
    SLOAD(sB, KVBLK); if (SD == 2 && 2 < NT) SLOAD(sA, 2 * KVBLK);
    SWRITE(1, sB); __syncthreads();
    for (int j = 1; j + 1 < NT; j += 2) {
        SBAR(); qkt<DQ>(pB0, pB1, K_lds + SHM_K, qr, r32, hi, negm);
        finishSM(pA0, pA1, alA, l_reg, pa0, pa1, pa2, pa3); SBAR();
        SLOAD(sB, (j + SD) * KVBLK); SBAR();
        pv_all<DV>(o, vb0, pa0, pa1, pa2, pa3); PSM(pB0, pB1, mnB, alB);
        __syncthreads(); SWRITE(0, sA);
        RESCX(alB); __syncthreads();
        SBAR(); qkt<DQ>(pA0, pA1, K_lds, qr, r32, hi, negm);
        finishSM(pB0, pB1, alB, l_reg, pa0, pa1, pa2, pa3); SBAR();
        if (SD == 1 || j + 3 < NT) SLOAD(sA, (j + 1 + SD) * KVBLK); SBAR();
        pv_all<DV>(o, vb0 + SHM_V, pa0, pa1, pa2, pa3); PSM(pA0, pA1, mnA, alA);
        __syncthreads(); SWRITE(1, sB);
        RESCX(alA); __syncthreads();
    }
    SBAR(); qkt<DQ>(pB0, pB1, K_lds + SHM_K, qr, r32, hi, negm);
    finishSM(pA0, pA1, alA, l_reg, pa0, pa1, pa2, pa3); SBAR();
    pv_all<DV>(o, vb0, pa0, pa1, pa2, pa3); PSM(pB0, pB1, mnB, alB);
    __syncthreads(); RESCX(alB);
    finishSM(pB0, pB1, alB, l_reg, pa0, pa1, pa2, pa3); SBAR();
    pv_all<DV>(o, vb0 + SHM_V, pa0, pa1, pa2, pa3);
#undef PSM
#undef RESCX
    if (hi == 0) li_l[r32] = l_reg; asm volatile("s_waitcnt lgkmcnt(0)" ::: "memory");
    float rli[16];
#pragma unroll
    for (int r = 0; r < 16; ++r) rli[r] = __builtin_amdgcn_rcpf(li_l[crow(r, hi)]);
    bf16_t* Ow = OG + (size_t)(wid * QBLK) * ldo + r32;
    float gte[NO][16];
#pragma unroll
    for (int r = 0; r < 16; ++r)
#pragma unroll
        for (int d0 = 0; d0 < NO; ++d0) gte[d0][r] = bf1(Ow[(size_t)crow(r, hi) * ldo + d0 * 32]);
#pragma unroll
    for (int r = 0; r < 16; ++r)
#pragma unroll
        for (int d0 = 0; d0 < NO; ++d0) Ow[(size_t)crow(r, hi) * ldo + d0 * 32] = (bf16_t)(cvtpk(o[d0][r] * rli[r] * gte[d0][r], 0.f) & 0xffffu);
    __syncthreads();
#undef SLOAD
#undef SWRITE
#undef RESC
}

template <int ldq, int ldo>
__device__ __forceinline__ void attn_fast3(const bf16_t* Qb, const bf16_t* Kh, const bf16_t* Vh, bf16_t* OG, int seq, char* lds, const int tid, const float* qn, float kmax) {
    constexpr int DQ = 96, DV = 64, NQ = DQ / 16, NO = DV / 32, SHM_V = KVBLK * DV * 2, KCH = DQ / 8, VCH = DV / 8;
    const int wid = tid >> 6, lane = tid & 63, r32 = lane & 31, hi = lane >> 5;
    char* K_lds = lds; char* V_lds = lds + 3 * SHM_K;
    float* li_l = (float*)(lds + 3 * SHM_K + 3 * SHM_V) + wid * 64;
    float l_reg = 0; f32x16 o[NO]; bf16x8 qr[NQ];
    const float negm = -(qn[(wid * QBLK + r32) * 8] * kmax);
#pragma unroll
    for (int d = 0; d < NO; ++d) o[d] = f32x16{};
    const bf16_t* Qw = Qb + (size_t)(wid * QBLK + r32) * ldq + hi * 8;
#pragma unroll
    for (int d0 = 0; d0 < NQ; ++d0) qr[d0] = *reinterpret_cast<const bf16x8*>(Qw + d0 * 16);
    const int kc0 = tid, kc1 = tid + 512;
    const int kl0 = KSWZ(kc0 / KCH, (kc0 % KCH) * 16), kl1 = KSWZ(kc1 / KCH, (kc1 % KCH) * 16);
    const bool k1on = (wid < 4);
    const int vl0 = v_st<DV>(tid / VCH, (tid % VCH) * 8);
    const int vb0 = (int)(uintptr_t)V_lds + v_rd_base(lane);
    struct Slot { bf16x8 v0, k0, k1; }; Slot sA, sB;
#define SLOAD3(S, key0) do { const bf16_t* kp_ = Kh + (size_t)(key0) * DQ; const bf16_t* vp_ = Vh + (size_t)(key0) * DV; \
        S.v0 = *reinterpret_cast<const bf16x8*>(vp_ + tid * 8); S.k0 = *reinterpret_cast<const bf16x8*>(kp_ + kc0 * 8); if (k1on) S.k1 = *reinterpret_cast<const bf16x8*>(kp_ + kc1 * 8); } while (0)
#define SWRITE3(b, S) do { *(bf16x8*)(V_lds + (b) * SHM_V + vl0) = S.v0; *(bf16x8*)(K_lds + (b) * SHM_K + kl0) = S.k0; if (k1on) *(bf16x8*)(K_lds + (b) * SHM_K + kl1) = S.k1; } while (0)
    f32x16 pA0, pA1, pB0, pB1; bf16x8 pa0, pa1, pa2, pa3; const int NT = seq / KVBLK;
    SLOAD3(sA, 0); SLOAD3(sB, KVBLK); SWRITE3(0, sA); SWRITE3(1, sB); SLOAD3(sA, 2 * KVBLK); __syncthreads();
    qkt<DQ>(pA0, pA1, K_lds, qr, r32, hi, negm); fastSM0(pA0);
#define STEP3(PQ0, PQ1, PF0, PF1, SL, SW, J, BX, BY, BZ, DOLOAD, DOWRITE) do { \
        SBAR(); qkt<DQ>(PQ0, PQ1, K_lds + (BY) * SHM_K, qr, r32, hi, negm); \
        { float al_ = 1.f; finishSM(PF0, PF1, al_, l_reg, pa0, pa1, pa2, pa3); } __builtin_amdgcn_sched_group_barrier(0x100, 12, 0); SBAR(); \
        if (DOLOAD) SLOAD3(SL, ((J) + 3) * KVBLK); SBAR(); \
        pv_all<DV>(o, vb0 + (BX) * SHM_V, pa0, pa1, pa2, pa3); fastSM0(PQ0); \
        if (DOWRITE) SWRITE3(BZ, SW); \
        __syncthreads(); } while (0)
    int j = 0;
    for (; j + 6 < NT - 3; j += 6) {
        STEP3(pB0, pB1, pA0, pA1, sB, sA, j + 0, 0, 1, 2, true, true);
        STEP3(pA0, pA1, pB0, pB1, sA, sB, j + 1, 1, 2, 0, true, true);
        STEP3(pB0, pB1, pA0, pA1, sB, sA, j + 2, 2, 0, 1, true, true);
        STEP3(pA0, pA1, pB0, pB1, sA, sB, j + 3, 0, 1, 2, true, true);
        STEP3(pB0, pB1, pA0, pA1, sB, sA, j + 4, 1, 2, 0, true, true);
        STEP3(pA0, pA1, pB0, pB1, sA, sB, j + 5, 2, 0, 1, true, true);
    }
    STEP3(pB0, pB1, pA0, pA1, sB, sA, j + 0, 0, 1, 2, true, true);
    STEP3(pA0, pA1, pB0, pB1, sA, sB, j + 1, 1, 2, 0, false, true);
    STEP3(pB0, pB1, pA0, pA1, sB, sA, j + 2, 2, 0, 1, false, false);
    SBAR(); { float al_ = 1.f; finishSM(pB0, pB1, al_, l_reg, pa0, pa1, pa2, pa3); } SBAR();
    pv_all<DV>(o, vb0 + 0 * SHM_V, pa0, pa1, pa2, pa3);
#undef STEP3
#undef SLOAD3
#undef SWRITE3
    if (hi == 0) li_l[r32] = l_reg; asm volatile("s_waitcnt lgkmcnt(0)" ::: "memory");
    float rli[16];
#pragma unroll
    for (int r = 0; r < 16; ++r) rli[r] = __builtin_amdgcn_rcpf(li_l[crow(r, hi)]);
    bf16_t* Ow = OG + (size_t)(wid * QBLK) * ldo + r32;
    float gte[NO][16];
#pragma unroll
    for (int r = 0; r < 16; ++r)
#pragma unroll
        for (int d0 = 0; d0 < NO; ++d0) gte[d0][r] = bf1(Ow[(size_t)crow(r, hi) * ldo + d0 * 32]);
#pragma unroll
    for (int r = 0; r < 16; ++r)
#pragma unroll
        for (int d0 = 0; d0 < NO; ++d0) Ow[(size_t)crow(r, hi) * ldo + d0 * 32] = (bf16_t)(cvtpk(o[d0][r] * rli[r] * gte[d0][r], 0.f) & 0xffffu);
    __syncthreads();
}

template <int ldq, int ldo>
__device__ __forceinline__ void attn_dma4(const bf16_t* Qb, const bf16_t* Kh, const bf16_t* Vh, bf16_t* OG, int seq, char* lds, const int tid, const float* qn, float kmax) {
    constexpr int DQ = 96, DV = 64, NQ = DQ / 16, NO = DV / 32, SHM_V = KVBLK * DV * 2;
    const int wid = __builtin_amdgcn_readfirstlane(tid >> 6), lane = tid & 63, r32 = lane & 31, hi = lane >> 5;
    char* K_lds = lds; char* V_lds = lds + 4 * SHM_K;
    LAS unsigned char* Kl = (LAS unsigned char*)lds; LAS unsigned char* Vl = Kl + 4 * SHM_K;
    float* li_l = (float*)(lds + 4 * SHM_K + 4 * SHM_V) + wid * 64;
    float l_reg = 0; f32x16 o[NO]; bf16x8 qr[NQ];
    const float negm = -(qn[(wid * QBLK + r32) * 8] * kmax);
#pragma unroll
    for (int d = 0; d < NO; ++d) o[d] = f32x16{};
    const bf16_t* Qw = Qb + (size_t)(wid * QBLK + r32) * ldq + hi * 8;
#pragma unroll
    for (int d0 = 0; d0 < NQ; ++d0) qr[d0] = *reinterpret_cast<const bf16x8*>(Qw + d0 * 16);
    int kofs0, kofs1, vofs;
    { const int rowa = 4 * wid + (lane >> 4), rowb = rowa + 32, slot = lane & 15;
      const int fa = (rowa & 7) | (((rowa >> 4) & 1) << 3), fb = (rowb & 7) | (((rowb >> 4) & 1) << 3);
      const int ca = slot ^ fa, cb = slot ^ fb;
      kofs0 = rowa * DQ + (ca < 12 ? ca * 8 : 0); kofs1 = rowb * DQ + (cb < 12 ? cb * 8 : 0);
      const int sidx = wid * 64 + lane, sub = sidx >> 5, within = sidx & 31, kk = (sub >> 1) * 8 + (within >> 2), cc = (sub & 1) * 32 + (within & 3) * 8;
      const int key = (kk & ~0xC) | ((kk & 4) << 1) | ((kk & 8) >> 1);
      vofs = key * DV + cc; }
    const int vb0 = (int)(uintptr_t)V_lds + v_rd_base(lane);
#define DMA_TILE(T, SLOT) do { const bf16_t* kp_ = Kh + (size_t)(T) * (KVBLK * DQ); const bf16_t* vp_ = Vh + (size_t)(T) * (KVBLK * DV); \
        __builtin_amdgcn_global_load_lds((const unsigned*)(kp_ + kofs0), (LAS unsigned*)(Kl + (SLOT) * SHM_K + wid * 1024), 16, 0, 0); \
        __builtin_amdgcn_global_load_lds((const unsigned*)(kp_ + kofs1), (LAS unsigned*)(Kl + (SLOT) * SHM_K + 8192 + wid * 1024), 16, 0, 0); \
        __builtin_amdgcn_global_load_lds((const unsigned*)(vp_ + vofs), (LAS unsigned*)(Vl + (SLOT) * SHM_V + wid * 1024), 16, 0, 0); } while (0)
#define BAR_DMA(N) do { asm volatile("s_waitcnt vmcnt(" #N ")" ::: "memory"); asm volatile("s_waitcnt lgkmcnt(0)" ::: "memory"); __builtin_amdgcn_s_barrier(); asm volatile("" ::: "memory"); SBAR(); } while (0)
    f32x16 pA0, pA1, pB0, pB1; bf16x8 pa0, pa1, pa2, pa3; const int NT = seq / KVBLK;
    asm volatile("s_waitcnt lgkmcnt(0)" ::: "memory"); __builtin_amdgcn_s_barrier(); asm volatile("" ::: "memory");
    DMA_TILE(0, 0); DMA_TILE(1, 1); DMA_TILE(2, 2);
    BAR_DMA(3);
    qkt<DQ>(pA0, pA1, K_lds, qr, r32, hi, negm); fastSM0(pA0);
#define STEPD(PQ0, PQ1, PF0, PF1, J, S0, DOLOAD) do { \
        SBAR(); qkt<DQ>(PQ0, PQ1, K_lds + (((S0) + 1) & 3) * SHM_K, qr, r32, hi, negm); \
        { float al_ = 1.f; finishSM(PF0, PF1, al_, l_reg, pa0, pa1, pa2, pa3); } __builtin_amdgcn_sched_group_barrier(0x100, 12, 0); SBAR(); \
        if (DOLOAD) DMA_TILE((J) + 3, ((S0) + 3) & 3); SBAR(); \
        pv_all<DV>(o, vb0 + (S0) * SHM_V, pa0, pa1, pa2, pa3); fastSM0(PQ0); \
        if (DOLOAD) BAR_DMA(3); else BAR_DMA(0); } while (0)
    int j = 0;
    for (; j + 4 <= NT - 4; j += 4) {
        STEPD(pB0, pB1, pA0, pA1, j + 0, 0, true); STEPD(pA0, pA1, pB0, pB1, j + 1, 1, true);
        STEPD(pB0, pB1, pA0, pA1, j + 2, 2, true); STEPD(pA0, pA1, pB0, pB1, j + 3, 3, true);
    }
    STEPD(pB0, pB1, pA0, pA1, j + 0, 0, true);
    STEPD(pA0, pA1, pB0, pB1, j + 1, 1, false);
    STEPD(pB0, pB1, pA0, pA1, j + 2, 2, false);
    SBAR(); { float al_ = 1.f; finishSM(pB0, pB1, al_, l_reg, pa0, pa1, pa2, pa3); } SBAR();
    pv_all<DV>(o, vb0 + 3 * SHM_V, pa0, pa1, pa2, pa3);
#undef STEPD
#undef DMA_TILE
#undef BAR_DMA
    if (hi == 0) li_l[r32] = l_reg; asm volatile("s_waitcnt lgkmcnt(0)" ::: "memory");
    float rli[16];
#pragma unroll
    for (int r = 0; r < 16; ++r) rli[r] = __builtin_amdgcn_rcpf(li_l[crow(r, hi)]);
    bf16_t* Ow = OG + (size_t)(wid * QBLK) * ldo + r32;
    float gte[NO][16];
#pragma unroll
    for (int r = 0; r < 16; ++r)
#pragma unroll
        for (int d0 = 0; d0 < NO; ++d0) gte[d0][r] = bf1(Ow[(size_t)crow(r, hi) * ldo + d0 * 32]);
#pragma unroll
    for (int r = 0; r < 16; ++r)
#pragma unroll
        for (int d0 = 0; d0 < NO; ++d0) Ow[(size_t)crow(r, hi) * ldo + d0 * 32] = (bf16_t)(cvtpk(o[d0][r] * rli[r] * gte[d0][r], 0.f) & 0xffffu);
    __syncthreads();
}

template <int ldq, int ldo>
__device__ __forceinline__ void attn_mem(const bf16_t* Qb, const bf16_t* Kh, const bf16_t* Vh, bf16_t* OG, char* lds, const int tid) {
    constexpr int DQ = 128, DV = 128, NQ = DQ / 16, NO = DV / 32, SHM_V = KVBLK * DV * 2, NT = 4;
    const int wid = __builtin_amdgcn_readfirstlane(tid >> 6), lane = tid & 63, r32 = lane & 31, hi = lane >> 5;
    char* K_lds = lds; char* V_lds = lds + NT * SHM_K;
    LAS unsigned char* Kl = (LAS unsigned char*)lds; LAS unsigned char* Vl = Kl + NT * SHM_K;
    float* wsf = (float*)(lds + LDS_SCR_OFF) + wid * 64; float* li_l = wsf; float* al_l = wsf + 32;
    int kofs, vofs0, vofs1;
    { const int rowa = 4 * wid + (lane >> 4), slot = lane & 15, fa = (rowa & 7) | (((rowa >> 4) & 1) << 3);
      kofs = rowa * DQ + (slot ^ fa) * 8;
      const int s0 = wid * 64 + lane, s1 = (wid + 8) * 64 + lane;
      { const int sub = s0 >> 5, within = s0 & 31, kk = (sub >> 2) * 8 + (within >> 2), cc = (sub & 3) * 32 + (within & 3) * 8; vofs0 = ((kk & ~0xC) | ((kk & 4) << 1) | ((kk & 8) >> 1)) * DV + cc; }
      { const int sub = s1 >> 5, within = s1 & 31, kk = (sub >> 2) * 8 + (within >> 2), cc = (sub & 3) * 32 + (within & 3) * 8; vofs1 = ((kk & ~0xC) | ((kk & 4) << 1) | ((kk & 8) >> 1)) * DV + cc; } }
    const int vb0 = (int)(uintptr_t)V_lds + v_rd_base(lane);
    asm volatile("s_waitcnt lgkmcnt(0)" ::: "memory"); __builtin_amdgcn_s_barrier(); asm volatile("" ::: "memory");
#pragma unroll
    for (int i = 0; i < 8; ++i)
        __builtin_amdgcn_global_load_lds((const unsigned*)(Kh + kofs + i * 32 * DQ), (LAS unsigned*)(Kl + (wid + 8 * i) * 1024), 16, 0, 0);
#pragma unroll
    for (int t = 0; t < NT; ++t) {
        __builtin_amdgcn_global_load_lds((const unsigned*)(Vh + t * KVBLK * DV + vofs0), (LAS unsigned*)(Vl + t * SHM_V + wid * 1024), 16, 0, 0);
        __builtin_amdgcn_global_load_lds((const unsigned*)(Vh + t * KVBLK * DV + vofs1), (LAS unsigned*)(Vl + t * SHM_V + (wid + 8) * 1024), 16, 0, 0); }
    bf16x8 qr[NQ]; f32x16 o[NO]; float m_reg = -1e30f, l_reg = 0.f;
#pragma unroll
    for (int d = 0; d < NO; ++d) o[d] = f32x16{};
    const bf16_t* Qw = Qb + (size_t)(wid * QBLK + r32) * ldq + hi * 8;
#pragma unroll
    for (int d0 = 0; d0 < NQ; ++d0) qr[d0] = *reinterpret_cast<const bf16x8*>(Qw + d0 * 16);
    asm volatile("s_waitcnt vmcnt(0)" ::: "memory"); asm volatile("s_waitcnt lgkmcnt(0)" ::: "memory"); __builtin_amdgcn_s_barrier(); asm volatile("" ::: "memory"); SBAR();
    f32x16 p0, p1; bf16x8 pa0, pa1, pa2, pa3;
#pragma unroll
    for (int t = 0; t < NT; ++t) {
        float mn, al;
        qkt<DQ>(p0, p1, K_lds + t * SHM_K, qr, r32, hi, 0.f);
        partialSM<DQ, false>(p0, p1, m_reg, mn, al);
        if (__any(al < 1.f)) { if (hi == 0) al_l[r32] = al; asm volatile("s_waitcnt lgkmcnt(0)" ::: "memory");
#pragma unroll
            for (int d = 0; d < NO; ++d)
#pragma unroll
                for (int r = 0; r < 16; ++r) o[d][r] *= al_l[crow(r, hi)]; }
        finishSM(p0, p1, al, l_reg, pa0, pa1, pa2, pa3); SBAR();
        pv_all<DV>(o, vb0 + t * SHM_V, pa0, pa1, pa2, pa3);
    }
    if (hi == 0) li_l[r32] = l_reg; asm volatile("s_waitcnt lgkmcnt(0)" ::: "memory");
    float rli[16];
#pragma unroll
    for (int r = 0; r < 16; ++r) rli[r] = __builtin_amdgcn_rcpf(li_l[crow(r, hi)]);
    bf16_t* Ow = OG + (size_t)(wid * QBLK) * ldo + r32;
#pragma unroll
    for (int dh = 0; dh < 2; ++dh) {
        float gte[2][16];
#pragma unroll
        for (int r = 0; r < 16; ++r)
#pragma unroll
            for (int d0 = 0; d0 < 2; ++d0) gte[d0][r] = bf1(Ow[(size_t)crow(r, hi) * ldo + (2 * dh + d0) * 32]);
#pragma unroll
        for (int r = 0; r < 16; ++r)
#pragma unroll
            for (int d0 = 0; d0 < 2; ++d0) Ow[(size_t)crow(r, hi) * ldo + (2 * dh + d0) * 32] = (bf16_t)(cvtpk(o[2 * dh + d0][r] * rli[r] * gte[d0][r], 0.f) & 0xffffu);
        asm volatile("" ::: "memory"); }
    __syncthreads();
}
}

constexpr int NWAVES = 8;
constexpr int LDS_BYTES = 135168, LDS_CTL_OFF = 132096;

struct Params {
    const float* x; const float* mem; const int* pos;
    const float *norm_g, *w_in, *b_gate, *q_norm_g, *w_uq, *kv_norm_g, *w_ukv, *q_head_g, *k_head_g, *conv_w, *conv_b, *mem_norm_g, *w_mkv, *mem_q_g, *mem_k_g,
                *w_br_attn, *w_br_conv, *w_br_mem, *w_out;
    float* out; unsigned char* ws;
    float inv_freq[16];
};

__device__ __forceinline__ void transpose_item(const float* W, int ldn, int K, const float* gain, bf16_t* WT, int k0, int n0src, int dstrow, LAS float* scr, int lane) {
#pragma unroll
    for (int i = 0; i < 8; ++i) { const int kk = 8 * i + (lane >> 3), c4 = (lane & 7) * 4; const float gn = gain ? gain[k0 + kk] : 1.f;
        const f32x4 v = *(const f32x4*)(W + (size_t)(k0 + kk) * ldn + n0src + c4);
        scr[kk * 33 + c4 + 0] = v.x * gn; scr[kk * 33 + c4 + 1] = v.y * gn; scr[kk * 33 + c4 + 2] = v.z * gn; scr[kk * 33 + c4 + 3] = v.w * gn; }
    asm volatile("s_waitcnt lgkmcnt(0)" ::: "memory");
    const int c = lane & 7;
#pragma unroll
    for (int j = 0; j < 4; ++j) { const int n = (lane >> 3) + 8 * j; const LAS float* s = scr + (8 * c) * 33 + n;
        u32x4 o; o.x = cvtpk(s[0 * 33], s[1 * 33]); o.y = cvtpk(s[2 * 33], s[3 * 33]); o.z = cvtpk(s[4 * 33], s[5 * 33]); o.w = cvtpk(s[6 * 33], s[7 * 33]);
        *(u32x4*)(WT + (size_t)(dstrow + n) * K + k0 + 8 * c) = o; }
    asm volatile("s_waitcnt lgkmcnt(0)" ::: "memory");
}
__device__ __forceinline__ int win_dst_col(int n) {
    if (n < 384) return C_QLAT + n;
    if (n < 640) return C_KVLAT + (n - 384);
    if (n < 672) return C_KPE + (n - 640);
    if (n < 1184) return C_CB + (n - 672);
    if (n < 1696) return C_CC + (n - 1184);
    if (n < 2208) return C_CU + (n - 1696);
    if (n < 2720) return C_QMEM + (n - 2208);
    if (n < 3232) return C_GATTN + (n - 2720);
    if (n < 3744) return C_GCONV + (n - 3232);
    if (n < 4256) return C_GMEM + (n - 3744);
    return n - 4256;
}
__device__ __forceinline__ void rows_to_bf16(const float* xin, bf16_t* xb, float* rstd, int rows, int gw, int NGW, int lane) {
    for (int m = gw; m < rows; m += NGW) {
        const f32x4* xr = (const f32x4*)(xin + (size_t)m * 1024) + lane;
        f32x4 v[4]; float s = 0.f;
#pragma unroll
        for (int j = 0; j < 4; ++j) { v[j] = xr[64 * j]; s += (v[j].x * v[j].x + v[j].y * v[j].y) + (v[j].z * v[j].z + v[j].w * v[j].w); }
        s = wave_sum(s);
        if (lane == 0) rstd[m] = rsqrtf(s * (1.f / 1024.f) + EPS);
        u32x2* o8 = (u32x2*)(xb + (size_t)m * 1024) + lane;
#pragma unroll
        for (int j = 0; j < 4; ++j) { u32x2 w; w.x = cvtpk(v[j].x, v[j].y); w.y = cvtpk(v[j].z, v[j].w); o8[64 * j] = w; }
    }
}

#define XB_TMO      128
#define XB_XCNT(j)  (256  + 64 * (j))
#define XB_XSUB(j)  (1280 + 64 * (j))
#define XB_XGEN(j)  (2304 + 64 * (j))
#define XB_TOP      3328
#define XB_TOPGEN   3392
#define XCD_BAR_WORDS 3456
#define XB_SPIN_CAP (1u << 18)
__device__ __forceinline__ unsigned xb_ld(unsigned* p)              { return __hip_atomic_load(p, __ATOMIC_RELAXED, __HIP_MEMORY_SCOPE_AGENT); }
__device__ __forceinline__ unsigned xb_add(unsigned* p, unsigned v) { return __hip_atomic_fetch_add(p, v, __ATOMIC_RELAXED, __HIP_MEMORY_SCOPE_AGENT); }
__device__ __forceinline__ unsigned xb_xcc_id() { return (unsigned)__builtin_amdgcn_s_getreg((3 << 11) | 20) & 0xFu; }
#define XB_SPIN(cond, bar) do { unsigned _sp = 0; while (cond) { __builtin_amdgcn_s_sleep(1); \
    if ((++_sp & 255u) == 0u) { if (xb_ld(&(bar)[XB_TMO])) break; if (_sp > XB_SPIN_CAP) { atomicAdd(&(bar)[XB_TMO], 1u); break; } } } } while (0)
struct XcdBarrier { unsigned* bar; unsigned x; volatile LAS unsigned* st; };
__device__ __forceinline__ XcdBarrier xcd_barrier_post(unsigned* bar, volatile LAS unsigned* st) {
    XcdBarrier b; b.bar = bar; b.x = xb_xcc_id(); b.st = st;
    if (threadIdx.x == 0) (void)xb_add(&bar[XB_XCNT(b.x)], 1u);
    return b;
}
__device__ __forceinline__ void xcd_barrier_complete(unsigned* bar, unsigned x, unsigned& nloc, unsigned& nx) {
    const unsigned G = gridDim.x * gridDim.y * gridDim.z;
    unsigned sum, cnt, mine, sp = 0u;
    for (;;) {
        sum = 0u; cnt = 0u; mine = 0u;
#pragma unroll
        for (unsigned j = 0; j < 16; ++j) { const unsigned c = xb_ld(&bar[XB_XCNT(j)]); sum += c; cnt += (c > 0u) ? 1u : 0u; mine = (j == x) ? c : mine; }
        if (sum == G) break;
        __builtin_amdgcn_s_sleep(1);
        if ((++sp & 255u) == 0u) { if (xb_ld(&bar[XB_TMO])) break; if (sp > XB_SPIN_CAP) { atomicAdd(&bar[XB_TMO], 1u); break; } }
    }
    nloc = mine > 0u ? mine : 1u; nx = cnt > 0u ? cnt : 1u;
}
__device__ __forceinline__ void xcd_barrier(const XcdBarrier& b) {
    asm volatile("s_waitcnt vmcnt(0)" ::: "memory");
    __syncthreads();
    if (threadIdx.x == 0) {
        unsigned* bar = b.bar;
        __builtin_amdgcn_s_waitcnt(0);
        unsigned nloc = b.st[0], nx = b.st[1];
        if (nloc == 0u) { xcd_barrier_complete(bar, b.x, nloc, nx); b.st[0] = nloc; b.st[1] = nx; }
        const unsigned old = xb_add(&bar[XB_XSUB(b.x)], 1u);
        const unsigned gen = old / nloc;
        if (old + 1u == (gen + 1u) * nloc) {
            __builtin_amdgcn_fence(__ATOMIC_RELEASE, "agent");
            asm volatile("s_waitcnt vmcnt(0)" ::: "memory");
            const unsigned og = xb_add(&bar[XB_TOP], 1u);
            const unsigned tg = og / nx;
            if (og + 1u == (tg + 1u) * nx) xb_add(&bar[XB_TOPGEN], 1u);
            else XB_SPIN(xb_ld(&bar[XB_TOPGEN]) == tg, bar);
            __builtin_amdgcn_fence(__ATOMIC_ACQUIRE, "agent");
            xb_add(&bar[XB_XGEN(b.x)], 1u);
            asm volatile("s_waitcnt vmcnt(0)" ::: "memory");
        } else {
            XB_SPIN(xb_ld(&bar[XB_XGEN(b.x)]) == gen, bar);
            __builtin_amdgcn_fence(__ATOMIC_ACQUIRE, "agent");
            asm volatile("s_waitcnt vmcnt(0)" ::: "memory");
        }
    }
    __syncthreads();
}

enum { K_S0 = 0, K_S2, K_ROWS, K_CONV, K_QKV, K_MATT, K_ATT, K_NOP, K_G_MKV, K_G_IN, K_G_UQ, K_G_UKV, K_G_BC, K_G_BM, K_G_BA, K_G_OUT };
constexpr int STEPS_PER = 11, N_ITERS = DEPTH * NB, N_SETUP = 2, N_STEPS = N_SETUP + N_ITERS * STEPS_PER + 1;
__host__ __device__ __forceinline__ int step_kind(int s) {
    return s == 0 ? K_G_OUT : s == 1 ? K_G_IN : s == 2 ? K_G_UQ : s == 3 ? K_G_UKV : s == 4 ? K_CONV : s == 5 ? K_QKV : s == 6 ? K_MATT : s == 7 ? K_G_BC : s == 8 ? K_G_BM : s == 9 ? K_ATT : K_G_BA;
}
__host__ __device__ __forceinline__ bool step_sync(int s) { return (0x652 >> s) & 1; }

__global__ void __launch_bounds__(NWAVES * 64, 2) mega(Params p, int lo, int hi) {
    extern __shared__ __attribute__((aligned(16))) unsigned char lds[];
    cg::grid_group grid = cg::this_grid();
    LAS unsigned char* ldsl = (LAS unsigned char*)lds;
    const int G = gridDim.x, bx = blockIdx.x, NGW = G * NWAVES;
    unsigned char* ws = p.ws;
    bf16_t* WMKV = (bf16_t*)(ws + WS_WMKV); bf16_t* MEMB = (bf16_t*)(ws + WS_MEMB); bf16_t* MKVRAW = (bf16_t*)(ws + WS_MKVRAW);
    bf16_t* MK = (bf16_t*)(ws + WS_MK); bf16_t* MV = (bf16_t*)(ws + WS_MV); float* MRSTD = (float*)(ws + WS_MRSTD); float* RSTD = (float*)(ws + WS_RSTD);
    bf16_t* XB = (bf16_t*)(ws + WS_XB); bf16_t* PROJ = (bf16_t*)(ws + WS_PROJ); bf16_t* QRAW = (bf16_t*)(ws + WS_QRAW); bf16_t* KVRAW = (bf16_t*)(ws + WS_KVRAW);
    float* QN = (float*)(ws + WS_QN); float* KQMAX = (float*)(ws + WS_KQMAX);
    bf16_t* QF = (bf16_t*)(ws + WS_QF); bf16_t* KF = (bf16_t*)(ws + WS_KF); bf16_t* VF = (bf16_t*)(ws + WS_VF);
    if (threadIdx.x < 4) ((volatile LAS unsigned*)(ldsl + LDS_CTL_OFF))[threadIdx.x] = 0u;
    __syncthreads();
    const XcdBarrier xbar = xcd_barrier_post((unsigned*)(ws + WS_BAR), (volatile LAS unsigned*)(ldsl + LDS_CTL_OFF));
    for (int st = lo; st < hi; ++st) {
        int tidv = threadIdx.x; asm volatile("" : "+v"(tidv));
        const int tid = tidv, lane = tid & 63, wave = __builtin_amdgcn_readfirstlane(tid >> 6), gw = bx * NWAVES + wave;
        int kind, l = 0, b = 0; bool sync_after = true;
        if (st < N_SETUP) { kind = (st == 0) ? K_S0 : K_G_MKV; sync_after = (st == 0); }
        else { const int r = st - N_SETUP; int it;
            if (r == N_ITERS * STEPS_PER) { kind = K_G_OUT; it = N_ITERS - 1; }
            else { it = r / STEPS_PER; const int sidx = r % STEPS_PER; kind = step_kind(sidx); sync_after = step_sync(sidx);
                   if (sidx == 0) { if (it == 0) kind = K_NOP; else it -= 1; } }
            l = it >> 1; b = it & 1; }
        unsigned char* lw = ws + WS_LW + (size_t)l * LW_SIZE;
        const float* xin = (l == 0 ? p.x : (const float*)p.out) + (size_t)b * SEQ * 1024;
        float* xout = p.out + (size_t)b * SEQ * 1024;

#ifndef NO_GEMM
        if (kind >= K_G_MKV) {
            bf16_t* YB = KVRAW;
            pg8::Gemm g; pg8::EpiRT E; E.ldr = PJ; E.mode = 0; E.O = nullptr; E.ldc = PJ; E.rstd = nullptr; E.bias = nullptr; E.R = nullptr; E.Xin = nullptr; E.Xout = nullptr;
            g.M = SEQ; g.N = 1024; g.K = 512; g.lda = PJ;
            if (kind == K_G_MKV)      { g.A = MEMB; g.Bt = WMKV; g.M = NB * MEML; g.N = DEPTH * 1024; g.K = 1024; g.lda = 1024; E.O = MKVRAW; E.ldc = DEPTH * 1024; E.rstd = MRSTD; }
            else if (kind == K_G_IN)  { g.A = XB; g.Bt = (const bf16_t*)(lw + LW_WIN); g.N = PJ; g.K = 1024; g.lda = 1024; E.mode = 1; E.O = PROJ; E.rstd = RSTD; E.bias = p.b_gate + l * 3072; }
            else if (kind == K_G_UQ)  { g.A = PROJ + C_QLAT; g.Bt = (const bf16_t*)(lw + LW_WUQ); g.N = 768; g.K = 384; E.O = QRAW; E.ldc = 768; }
            else if (kind == K_G_UKV) { g.A = PROJ + C_KVLAT; g.Bt = (const bf16_t*)(lw + LW_WUKV); g.N = 1024; g.K = 256; E.O = KVRAW; E.ldc = 1024; }
            else if (kind == K_G_BC)  { g.A = PROJ + C_CB; g.Bt = (const bf16_t*)(lw + LW_WBC); E.mode = 2; E.O = YB; E.ldc = 1024; E.R = PROJ + C_RCONV; }
            else if (kind == K_G_BM)  { g.A = PROJ + C_GMEM; g.Bt = (const bf16_t*)(lw + LW_WBM); E.mode = 3; E.O = YB; E.ldc = 1024; E.R = PROJ + C_RMEM; }
            else if (kind == K_G_BA)  { g.A = PROJ + C_GATTN; g.Bt = (const bf16_t*)(lw + LW_WBA); E.mode = 3; E.O = YB; E.ldc = 1024; E.R = PROJ + C_RATTN; }
            else                      { g.A = YB; g.lda = 1024; g.Bt = (const bf16_t*)(lw + LW_WOUT); g.K = 1024; E.mode = 4; E.Xin = xin; E.Xout = xout; }
            pg8::StaticOrder S; S.init(g.M, g.N, G, bx);
            pg8::gemm_phase(ldsl, g, S, E, tid);
            if (kind == K_G_BA && (l * 2 + b) + 1 < DEPTH * NB) {
                const int ln = (l * 2 + b + 1) >> 1, bn = (l * 2 + b + 1) & 1;
                const float* xn = (ln == 0 ? p.x : (const float*)p.out) + (size_t)bn * SEQ * 1024;
                __syncthreads();
                rows_to_bf16(xn, XB, RSTD, SEQ, gw, NGW, lane);
                if (bx == 0 && tid < 16) KQMAX[tid] = 0.f;
            }
        }
#endif
#ifndef ONLY_GEMM
        if (kind == K_S0) {
            LAS float* scr = (LAS float*)(ldsl + wave * 16384);
            constexpr int I_IN = 16 * (INW / 32), I_UQ = 6 * 24, I_UKV = 4 * 32, I_MKV = 16 * 32, I_BR = 8 * 32, I_OUT = 16 * 32;
            constexpr int I_L = I_IN + I_UQ + I_UKV + I_MKV + 3 * I_BR + I_OUT;
            for (int it = gw; it < DEPTH * I_L; it += NGW) {
                const int ll = it / I_L; int r = it % I_L;
                unsigned char* lwl = ws + WS_LW + (size_t)ll * LW_SIZE;
                const float* src; const float* gain = nullptr; bf16_t* dst; int ldn, K, kb, nb, drow;
                if (r < I_IN) { const int nblk = INW / 32; kb = r / nblk; nb = r % nblk; src = p.w_in + (size_t)ll * 1024 * INW; ldn = INW; K = 1024; gain = p.norm_g + ll * 1024; dst = (bf16_t*)(lwl + LW_WIN); drow = win_dst_col(32 * nb); }
                else if ((r -= I_IN) < I_UQ) { kb = r / 24; nb = r % 24; src = p.w_uq + (size_t)ll * 384 * 768; ldn = 768; K = 384; gain = p.q_norm_g + ll * 384; dst = (bf16_t*)(lwl + LW_WUQ); drow = 32 * nb; }
                else if ((r -= I_UQ) < I_UKV) { kb = r / 32; nb = r % 32; src = p.w_ukv + (size_t)ll * 256 * 1024; ldn = 1024; K = 256; gain = p.kv_norm_g + ll * 256; dst = (bf16_t*)(lwl + LW_WUKV); drow = 32 * nb; }
                else if ((r -= I_UKV) < I_MKV) { kb = r / 32; nb = r % 32; src = p.w_mkv + (size_t)ll * 1024 * 1024; ldn = 1024; K = 1024; gain = p.mem_norm_g + ll * 1024; dst = WMKV; drow = ll * 1024 + 32 * nb; }
                else if ((r -= I_MKV) < 3 * I_BR) { const int which = r / I_BR, rr = r % I_BR; kb = rr / 32; nb = rr % 32;
                    src = (which == 0 ? p.w_br_attn : (which == 1 ? p.w_br_conv : p.w_br_mem)) + (size_t)ll * 512 * 1024; ldn = 1024; K = 512; dst = (bf16_t*)(lwl + LW_WBA + (size_t)which * SZ_WBR); drow = 32 * nb; }
                else { r -= 3 * I_BR; kb = r / 32; nb = r % 32; src = p.w_out + (size_t)ll * 1024 * 1024; ldn = 1024; K = 1024; dst = (bf16_t*)(lwl + LW_WOUT); drow = 32 * nb; }
                transpose_item(src, ldn, K, gain, dst, 64 * kb, 32 * nb, drow, scr, lane);
            }
            for (int i = bx * 512 + tid; i < DEPTH * 96 * 128; i += G * 512) { const int ll = i / (96 * 128), r = i % (96 * 128);
                *(u32x4*)(ws + WS_LW + (size_t)ll * LW_SIZE + LW_WIN + (size_t)INW * 2048 + (size_t)r * 16) = (u32x4){0u, 0u, 0u, 0u}; }
            rows_to_bf16(p.mem, MEMB, MRSTD, NB * MEML, gw, NGW, lane);
            rows_to_bf16(p.x, XB, RSTD, SEQ, gw, NGW, lane);
            if (bx == 0 && tid < 16) KQMAX[tid] = 0.f;
        }
        if (kind == K_CONV && l == 0 && b == 0) {
            for (int it = gw; it < NB * MEML * DEPTH; it += NGW) { const int m = it & 511, ll = it >> 9, bb = m >> 8, jr = m & 255;
                const bf16_t* src = MKVRAW + (size_t)m * 4096 + ll * 1024;
#pragma unroll
                for (int i = 0; i < 2; ++i) { const int c = lane + 64 * i, head = c >> 5, part = (c >> 4) & 1, d0 = (c & 15) * 8;
                    const u32x4 w = *(const u32x4*)(src + c * 8);
                    float ss = sumsq8(w); ss = sum16(ss);
                    const float rs = rsqrtf(ss * (1.f / 128.f) + EPS);
                    const float* gk = p.mem_k_g + ll * 128 + d0;
                    u32x4 o = w;
                    if (part == 0) { o.x = cvtpk(bflo(w.x) * rs * gk[0], bfhi(w.x) * rs * gk[1]); o.y = cvtpk(bflo(w.y) * rs * gk[2], bfhi(w.y) * rs * gk[3]);
                                     o.z = cvtpk(bflo(w.z) * rs * gk[4], bfhi(w.z) * rs * gk[5]); o.w = cvtpk(bflo(w.w) * rs * gk[6], bfhi(w.w) * rs * gk[7]); }
                    const size_t hb = (size_t)((ll * 2 + bb) * 4 + head) * 256 * 128;
                    bf16_t* dst = (part == 0) ? MK + hb + (size_t)jr * 128 + d0 : MV + hb + (size_t)jr * 128 + d0;
                    *(u32x4*)dst = o; }
            }
        }
        if (kind == K_ROWS) {
            rows_to_bf16(xin, XB, RSTD, SEQ, gw, NGW, lane);
            if (bx == 0 && tid < 16) KQMAX[tid] = 0.f;
        } else if (kind == K_CONV) {
            const float* cw = p.conv_w + l * 3 * 512; const float* cbv = p.conv_b + l * 512; const float* mqg = p.mem_q_g + l * 128;
            const int c0 = lane * 8;
            const f32x4 w0a = *(const f32x4*)(cw + c0), w0b = *(const f32x4*)(cw + c0 + 4), w1a = *(const f32x4*)(cw + 512 + c0), w1b = *(const f32x4*)(cw + 512 + c0 + 4);
            const f32x4 w2a = *(const f32x4*)(cw + 1024 + c0), w2b = *(const f32x4*)(cw + 1024 + c0 + 4), bia = *(const f32x4*)(cbv + c0), bib = *(const f32x4*)(cbv + c0 + 4);
            const f32x4 gqa = *(const f32x4*)(mqg + (lane & 15) * 8), gqb = *(const f32x4*)(mqg + (lane & 15) * 8 + 4);
            const float W0[8] = {w0a.x, w0a.y, w0a.z, w0a.w, w0b.x, w0b.y, w0b.z, w0b.w}, W1[8] = {w1a.x, w1a.y, w1a.z, w1a.w, w1b.x, w1b.y, w1b.z, w1b.w};
            const float W2[8] = {w2a.x, w2a.y, w2a.z, w2a.w, w2b.x, w2b.y, w2b.z, w2b.w}, BI[8] = {bia.x, bia.y, bia.z, bia.w, bib.x, bib.y, bib.z, bib.w};
            const float gq[8] = {gqa.x, gqa.y, gqa.z, gqa.w, gqb.x, gqb.y, gqb.z, gqb.w};
            for (int t = gw; t < SEQ; t += NGW) {
                bf16_t* pr = PROJ + (size_t)t * PJ;
                const u32x4 z4 = (u32x4){0u, 0u, 0u, 0u};
                const u32x4 cc0 = *(const u32x4*)(pr + C_CC + c0), cu0 = *(const u32x4*)(pr + C_CU + c0);
                const u32x4 ccm = t > 0 ? *(const u32x4*)(pr - PJ + C_CC + c0) : z4, cum = t > 0 ? *(const u32x4*)(pr - PJ + C_CU + c0) : z4;
                const u32x4 ccp = t < SEQ - 1 ? *(const u32x4*)(pr + PJ + C_CC + c0) : z4, cup = t < SEQ - 1 ? *(const u32x4*)(pr + PJ + C_CU + c0) : z4;
                const u32x4 cb = *(const u32x4*)(pr + C_CB + c0), gc = *(const u32x4*)(pr + C_GCONV + c0);
                const u32x4 qm = *(const u32x4*)(pr + C_QMEM + c0);
                u32x4 oc;
#pragma unroll
                for (int i = 0; i < 4; ++i) {
                    const float lo_ = bflo(cb[i]) * (W0[2 * i] * bflo(ccm[i]) * bflo(cum[i]) + W1[2 * i] * bflo(cc0[i]) * bflo(cu0[i]) + W2[2 * i] * bflo(ccp[i]) * bflo(cup[i]) + BI[2 * i]) * bflo(gc[i]);
                    const float hi_ = bfhi(cb[i]) * (W0[2 * i + 1] * bfhi(ccm[i]) * bfhi(cum[i]) + W1[2 * i + 1] * bfhi(cc0[i]) * bfhi(cu0[i]) + W2[2 * i + 1] * bfhi(ccp[i]) * bfhi(cup[i]) + BI[2 * i + 1]) * bfhi(gc[i]);
                    oc[i] = cvtpk(lo_, hi_);
                }
                *(u32x4*)(pr + C_CB + c0) = oc;
                float ss = sumsq8(qm); ss = sum16(ss);
                const float rs = rsqrtf(ss * (1.f / 128.f) + EPS);
                u32x4 oq; oq.x = cvtpk(bflo(qm.x) * rs * gq[0], bfhi(qm.x) * rs * gq[1]); oq.y = cvtpk(bflo(qm.y) * rs * gq[2], bfhi(qm.y) * rs * gq[3]);
                oq.z = cvtpk(bflo(qm.z) * rs * gq[4], bfhi(qm.z) * rs * gq[5]); oq.w = cvtpk(bflo(qm.w) * rs * gq[6], bfhi(qm.w) * rs * gq[7]);
                *(u32x4*)(pr + C_QMEM + c0) = oq;
            }
        } else if (kind == K_QKV) {
            const float* qg = p.q_head_g + l * 96; const float* kg = p.k_head_g + l * 96;
            const int h = lane >> 3, j = lane & 7;
            const float if0 = p.inv_freq[2 * j], if1 = p.inv_freq[2 * j + 1];
            const f32x4 qga = *(const f32x4*)(qg + 8 * j), qgb = *(const f32x4*)(qg + 8 * j + 4), kga = *(const f32x4*)(kg + 8 * j), kgb = *(const f32x4*)(kg + 8 * j + 4);
            const float QG[8] = {qga.x, qga.y, qga.z, qga.w, qgb.x, qgb.y, qgb.z, qgb.w}, KG[8] = {kga.x, kga.y, kga.z, kga.w, kgb.x, kgb.y, kgb.z, kgb.w};
            const float qr0 = qg[64 + 2 * j], qr1 = qg[65 + 2 * j], qr2 = qg[80 + 2 * j], qr3 = qg[81 + 2 * j];
            const float kr0 = kg[64 + 2 * j], kr1 = kg[65 + 2 * j], kr2 = kg[80 + 2 * j], kr3 = kg[81 + 2 * j];
            constexpr float CQ = 0.10206207261596575f * 1.4426950408889634f;
            float qmax2 = 0.f, kmax2 = 0.f;
            for (int t = gw; t < SEQ; t += NGW) {
                const bf16_t* pr = PROJ + (size_t)t * PJ;
                float sq = 0.f, skv = 0.f;
                if (lane < 48) sq = sumsq8(*(const u32x4*)(pr + C_QLAT + lane * 8));
                if (lane < 32) skv = sumsq8(*(const u32x4*)(pr + C_KVLAT + lane * 8));
                sq = wave_sum(sq); skv = wave_sum(skv);
                const float rq = rsqrtf(sq * (1.f / 384.f) + EPS), rkv = rsqrtf(skv * (1.f / 256.f) + EPS);
                const float pf = (float)p.pos[b * SEQ + t];
                const float a0 = pf * if0, a1 = pf * if1;
                const double r0 = (double)a0 * 0.15915494309189535, r1 = (double)a1 * 0.15915494309189535;
                const float f0 = (float)(r0 - rint(r0)), f1 = (float)(r1 - rint(r1));
                const float c0 = __builtin_amdgcn_cosf(f0), s0 = __builtin_amdgcn_sinf(f0), c1 = __builtin_amdgcn_cosf(f1), s1 = __builtin_amdgcn_sinf(f1);
                {
                    const bf16_t* qp = QRAW + (size_t)t * 768 + h * 96;
                    const u32x4 qn = *(const u32x4*)(qp + 8 * j); const unsigned qa = *(const unsigned*)(qp + 64 + 2 * j), qb = *(const unsigned*)(qp + 80 + 2 * j);
                    float v0 = bflo(qn.x) * rq, v1 = bfhi(qn.x) * rq, v2 = bflo(qn.y) * rq, v3 = bfhi(qn.y) * rq, v4 = bflo(qn.z) * rq, v5 = bfhi(qn.z) * rq, v6 = bflo(qn.w) * rq, v7 = bfhi(qn.w) * rq;
                    float t10 = bflo(qa) * rq, t11 = bfhi(qa) * rq, t20 = bflo(qb) * rq, t21 = bfhi(qb) * rq;
                    float ss = (v0 * v0 + v1 * v1) + (v2 * v2 + v3 * v3) + (v4 * v4 + v5 * v5) + (v6 * v6 + v7 * v7) + (t10 * t10 + t11 * t11) + (t20 * t20 + t21 * t21);
                    ss = sum8(ss);
                    const float rh = rsqrtf(ss * (1.f / 96.f) + EPS);
                    const float rc = rh * CQ;
                    v0 *= rc * QG[0]; v1 *= rc * QG[1]; v2 *= rc * QG[2]; v3 *= rc * QG[3]; v4 *= rc * QG[4]; v5 *= rc * QG[5]; v6 *= rc * QG[6]; v7 *= rc * QG[7];
                    t10 *= rc * qr0; t11 *= rc * qr1; t20 *= rc * qr2; t21 *= rc * qr3;
                    float n2 = (v0 * v0 + v1 * v1) + (v2 * v2 + v3 * v3) + (v4 * v4 + v5 * v5) + (v6 * v6 + v7 * v7) + (t10 * t10 + t11 * t11) + (t20 * t20 + t21 * t21);
                    n2 = sum8(n2);
                    qmax2 = fmaxf(qmax2, n2); if (j == 0) QN[(size_t)t * 8 + h] = sqrtf(n2);
                    u32x4 o; o.x = cvtpk(v0, v1); o.y = cvtpk(v2, v3); o.z = cvtpk(v4, v5); o.w = cvtpk(v6, v7);
                    bf16_t* qo = QF + (size_t)t * 768 + h * 96;
                    *(u32x4*)(qo + 8 * j) = o;
                    *(unsigned*)(qo + 64 + 2 * j) = cvtpk(t10 * c0 - t20 * s0, t11 * c1 - t21 * s1);
                    *(unsigned*)(qo + 80 + 2 * j) = cvtpk(t20 * c0 + t10 * s0, t21 * c1 + t11 * s1);
                }
                {
                    const bf16_t* kp = KVRAW + (size_t)t * 1024 + h * 128;
                    const u32x4 kn = *(const u32x4*)(kp + 8 * j), vv = *(const u32x4*)(kp + 64 + 8 * j);
                    const unsigned ka = *(const unsigned*)(pr + C_KPE + 2 * j), kb = *(const unsigned*)(pr + C_KPE + 16 + 2 * j);
                    float v0 = bflo(kn.x) * rkv, v1 = bfhi(kn.x) * rkv, v2 = bflo(kn.y) * rkv, v3 = bfhi(kn.y) * rkv, v4 = bflo(kn.z) * rkv, v5 = bfhi(kn.z) * rkv, v6 = bflo(kn.w) * rkv, v7 = bfhi(kn.w) * rkv;
                    float t10 = bflo(ka), t11 = bfhi(ka), t20 = bflo(kb), t21 = bfhi(kb);
                    float ss = (v0 * v0 + v1 * v1) + (v2 * v2 + v3 * v3) + (v4 * v4 + v5 * v5) + (v6 * v6 + v7 * v7) + (t10 * t10 + t11 * t11) + (t20 * t20 + t21 * t21);
                    ss = sum8(ss);
                    const float rh = rsqrtf(ss * (1.f / 96.f) + EPS);
                    v0 *= rh * KG[0]; v1 *= rh * KG[1]; v2 *= rh * KG[2]; v3 *= rh * KG[3]; v4 *= rh * KG[4]; v5 *= rh * KG[5]; v6 *= rh * KG[6]; v7 *= rh * KG[7];
                    t10 *= rh * kr0; t11 *= rh * kr1; t20 *= rh * kr2; t21 *= rh * kr3;
                    float n2 = (v0 * v0 + v1 * v1) + (v2 * v2 + v3 * v3) + (v4 * v4 + v5 * v5) + (v6 * v6 + v7 * v7) + (t10 * t10 + t11 * t11) + (t20 * t20 + t21 * t21);
                    n2 = sum8(n2);
                    kmax2 = fmaxf(kmax2, n2);
                    u32x4 o; o.x = cvtpk(v0, v1); o.y = cvtpk(v2, v3); o.z = cvtpk(v4, v5); o.w = cvtpk(v6, v7);
                    bf16_t* ko = KF + ((size_t)h * SEQ + t) * 96;
                    *(u32x4*)(ko + 8 * j) = o;
                    *(unsigned*)(ko + 64 + 2 * j) = cvtpk(t10 * c0 - t20 * s0, t11 * c1 - t21 * s1);
                    *(unsigned*)(ko + 80 + 2 * j) = cvtpk(t20 * c0 + t10 * s0, t21 * c1 + t11 * s1);
                    u32x4 ov; ov.x = cvtpk(bflo(vv.x) * rkv, bfhi(vv.x) * rkv); ov.y = cvtpk(bflo(vv.y) * rkv, bfhi(vv.y) * rkv); ov.z = cvtpk(bflo(vv.z) * rkv, bfhi(vv.z) * rkv); ov.w = cvtpk(bflo(vv.w) * rkv, bfhi(vv.w) * rkv);
                    *(u32x4*)(VF + ((size_t)h * SEQ + t) * 64 + 8 * j) = ov;
                }
            }
            {
                LAS float* red = (LAS float*)ldsl;
                if (j == 0) { red[wave * 16 + h] = qmax2; red[wave * 16 + 8 + h] = kmax2; }
                __syncthreads();
                if (tid < 16) { float mx = 0.f;
#pragma unroll
                    for (int w = 0; w < NWAVES; ++w) mx = fmaxf(mx, red[w * 16 + tid]);
                    atomicMax((unsigned*)KQMAX + tid, __float_as_uint(mx)); }
            }
        } else if (kind == K_MATT) {
#ifndef NO_MATT
            for (int u = bx; u < 4 * (SEQ / 256); u += G) { const int hm = u & 3, qb = u >> 2;
                const size_t kvoff = ((size_t)((l * 2 + b) * 4 + hm) * 256) * 128;
                att::attn_mem<PJ, PJ>(PROJ + (size_t)qb * 256 * PJ + C_QMEM + hm * 128, MK + kvoff, MV + kvoff, PROJ + (size_t)qb * 256 * PJ + C_GMEM + hm * 128, (char*)lds, tid);
            }
#endif
        } else if (kind == K_ATT) {
#ifndef NO_ATT
            { int tf = tid; asm volatile("" : "+v"(tf));
              for (int u = bx; u < NH * (SEQ / 256); u += G) { const int hh = u & 7, qb = u >> 3;
                const float kmx = sqrtf(KQMAX[8 + hh]), qmx = sqrtf(KQMAX[hh]);
                if (qmx * kmx <= 60.f)
                    att::attn_dma4<768, PJ>(QF + (size_t)qb * 256 * 768 + hh * 96, KF + (size_t)hh * SEQ * 96, VF + (size_t)hh * SEQ * 64,
                                       PROJ + (size_t)qb * 256 * PJ + C_GATTN + hh * 64, SEQ, (char*)lds, tf, QN + (size_t)qb * 256 * 8 + hh, kmx);
              } }
            { int ts = tid; asm volatile("" : "+v"(ts));
              for (int u = bx; u < NH * (SEQ / 256); u += G) { const int hh = u & 7, qb = u >> 3;
                const float kmx = sqrtf(KQMAX[8 + hh]), qmx = sqrtf(KQMAX[hh]);
                if (!(qmx * kmx <= 60.f))
                    att::attn_unit<96, 64, 1, 768, PJ, true, false>(QF + (size_t)qb * 256 * 768 + hh * 96, KF + (size_t)hh * SEQ * 96, VF + (size_t)hh * SEQ * 64,
                                       PROJ + (size_t)qb * 256 * PJ + C_GATTN + hh * 64, SEQ, (char*)lds, ts, nullptr, 0.f);
              } }
#endif
        }
#endif
        __syncthreads();
        if (sync_after && st + 1 < hi) { if (lo < 0) grid.sync(); else xcd_barrier(xbar); }
    }
}

extern "C" void kernel_launch(void* const* d_in, const int* in_sizes, int n_in, void* d_out, int out_size, void* d_ws, size_t ws_size, hipStream_t stream) {
    static int grid = 0;
    if (grid == 0) {
        if (n_in != 22 || in_sizes[0] != NB * SEQ * DM || out_size != NB * SEQ * DM || ws_size < WS_END) {
            fprintf(stderr, "kernel_launch: shape/workspace mismatch: n_in %d in0 %d out %d ws %zu (need %zu)\n", n_in, n_in > 0 ? in_sizes[0] : -1, out_size, ws_size, (size_t)WS_END); grid = -1; return; }
        int dev = 0, cus = 0, per_cu = 0;
        if (hipGetDevice(&dev) != hipSuccess || hipDeviceGetAttribute(&cus, hipDeviceAttributeMultiprocessorCount, dev) != hipSuccess) { grid = -1; return; }
        if (hipFuncSetAttribute((const void*)mega, hipFuncAttributeMaxDynamicSharedMemorySize, LDS_BYTES) != hipSuccess) { fprintf(stderr, "kernel_launch: hipFuncSetAttribute failed\n"); grid = -1; return; }
        if (hipOccupancyMaxActiveBlocksPerMultiprocessor(&per_cu, (const void*)mega, NWAVES * 64, LDS_BYTES) != hipSuccess || per_cu < 1) { fprintf(stderr, "kernel_launch: occupancy query gave %d\n", per_cu); per_cu = 1; }
        (void)hipGetLastError();
        grid = cus * 1;
    }
    if (grid < 0) return;
    Params p{};
    p.x = (const float*)d_in[0]; p.mem = (const float*)d_in[1]; p.pos = (const int*)d_in[2];
    p.norm_g = (const float*)d_in[3]; p.w_in = (const float*)d_in[4]; p.b_gate = (const float*)d_in[5]; p.q_norm_g = (const float*)d_in[6]; p.w_uq = (const float*)d_in[7];
    p.kv_norm_g = (const float*)d_in[8]; p.w_ukv = (const float*)d_in[9]; p.q_head_g = (const float*)d_in[10]; p.k_head_g = (const float*)d_in[11]; p.conv_w = (const float*)d_in[12];
    p.conv_b = (const float*)d_in[13]; p.mem_norm_g = (const float*)d_in[14]; p.w_mkv = (const float*)d_in[15]; p.mem_q_g = (const float*)d_in[16]; p.mem_k_g = (const float*)d_in[17];
    p.w_br_attn = (const float*)d_in[18]; p.w_br_conv = (const float*)d_in[19]; p.w_br_mem = (const float*)d_in[20]; p.w_out = (const float*)d_in[21];
    p.out = (float*)d_out; p.ws = (unsigned char*)d_ws;
    for (int i = 0; i < 16; ++i) p.inv_freq[i] = (float)pow(10000.0, -(double)i / 16.0);
    if (hipMemsetAsync((char*)d_ws + WS_BAR, 0, 16384, stream) != hipSuccess) { fprintf(stderr, "kernel_launch: memset failed\n"); return; }
#if MK_MULTI
    for (int st = 0; st < N_STEPS;) { int e = st;
        for (;;) { const bool sy = (e < 3) ? true : step_sync((e - 3) % STEPS_PER); ++e; if (sy || e >= N_STEPS) break; }
        hipLaunchKernelGGL(mega, dim3(grid), dim3(NWAVES * 64), LDS_BYTES, stream, p, st, e); st = e; }
#else
    int lo = 0, hi = N_STEPS;
    void* args[] = {&p, &lo, &hi};
    const hipError_t e = hipLaunchCooperativeKernel((const void*)mega, dim3(grid), dim3(NWAVES * 64), args, LDS_BYTES, stream);
    if (e != hipSuccess) fprintf(stderr, "kernel_launch: cooperative launch failed: %s (grid %d)\n", hipGetErrorString(e), grid);
#endif
}
```

```cpp
#include <hip/hip_runtime.h>
#include <hip/hip_cooperative_groups.h>
#include <cstdio>
#include <cstdint>
#include <cmath>
namespace cg = cooperative_groups;

#ifndef EN_MASK
#define EN_MASK 0xFFFF
#endif
#define EN(i) ((EN_MASK >> (i)) & 1)
#ifndef MK_MULTI
#define MK_MULTI 0
#endif

constexpr int DM = 1024, NB = 2, SEQ = 16384, DEPTH = 4, MEML = 256;
constexpr int NH = 8, QLR = 384, KVLR = 256;
constexpr int INW = 7328, PJ = 7424;
constexpr float EPS = 1e-6f;
constexpr int LDS_SCR_OFF = 132224;
constexpr int C_RATTN = 0, C_RCONV = 1024, C_RMEM = 2048, C_GATTN = 3072, C_GCONV = 3584, C_GMEM = 4096, C_CB = 4608, C_CC = 5120, C_CU = 5632,
              C_QMEM = 6144, C_KVLAT = 6656, C_QLAT = 6912, C_KPE = 7296;
constexpr size_t MiB = 1u << 20;
constexpr size_t SZ_WIN = (size_t)PJ * 1024 * 2, SZ_WUQ = 768 * 384 * 2, SZ_WUKV = 1024 * 256 * 2, SZ_WBR = 1024 * 512 * 2, SZ_WOUT = 1024 * 1024 * 2;
constexpr size_t LW_WIN = 0, LW_WUQ = LW_WIN + SZ_WIN, LW_WUKV = LW_WUQ + SZ_WUQ, LW_WBA = LW_WUKV + SZ_WUKV, LW_WBC = LW_WBA + SZ_WBR, LW_WBM = LW_WBC + SZ_WBR,
                 LW_WOUT = LW_WBM + SZ_WBR, LW_SIZE = LW_WOUT + SZ_WOUT;
constexpr size_t WS_LW = 0;
constexpr size_t WS_WMKV = ((WS_LW + 4 * LW_SIZE + 4095) / 4096) * 4096;
constexpr size_t WS_MEMB = WS_WMKV + 8 * MiB;
constexpr size_t WS_MKVRAW = WS_MEMB + 1 * MiB;
constexpr size_t WS_MK = WS_MKVRAW + 4 * MiB;
constexpr size_t WS_MV = WS_MK + 2 * MiB;
constexpr size_t WS_MRSTD = WS_MV + 2 * MiB;
constexpr size_t WS_RSTD = WS_MRSTD + 4096;
constexpr size_t WS_XB = WS_RSTD + 65536;
constexpr size_t WS_PROJ = WS_XB + 32 * MiB;
constexpr size_t WS_QRAW = WS_PROJ + (size_t)SEQ * PJ * 2;
constexpr size_t WS_KVRAW = WS_QRAW + 24 * MiB;
constexpr size_t WS_QF = WS_KVRAW + 32 * MiB;
constexpr size_t WS_KF = WS_QF + 24 * MiB;
constexpr size_t WS_VF = WS_KF + 24 * MiB;
constexpr size_t WS_BAR = WS_VF + 16 * MiB;
constexpr size_t WS_QN = WS_BAR + 16384;
constexpr size_t WS_KQMAX = WS_QN + (size_t)SEQ * 8 * 4;
constexpr size_t WS_END = WS_KQMAX + 256;

typedef unsigned short bf16_t;
typedef short bf16x8 __attribute__((ext_vector_type(8)));
typedef short s16x4 __attribute__((ext_vector_type(4)));
typedef float f32x4 __attribute__((ext_vector_type(4)));
typedef float f32x16 __attribute__((ext_vector_type(16)));
typedef unsigned u32x4 __attribute__((ext_vector_type(4)));
typedef unsigned u32x2 __attribute__((ext_vector_type(2)));
#define LAS __attribute__((address_space(3)))

__device__ __forceinline__ unsigned cvtpk(float lo, float hi) { unsigned r; asm volatile("v_cvt_pk_bf16_f32 %0, %1, %2" : "=v"(r) : "v"(lo), "v"(hi)); return r; }
__device__ __forceinline__ float bflo(unsigned w) { return __uint_as_float(w << 16); }
__device__ __forceinline__ float bfhi(unsigned w) { return __uint_as_float(w & 0xffff0000u); }
__device__ __forceinline__ float bf1(bf16_t h) { return __uint_as_float(((unsigned)h) << 16); }
__device__ __forceinline__ float sigmoidf_(float v) { return __builtin_amdgcn_rcpf(1.f + __builtin_amdgcn_exp2f(-1.4426950408889634f * v)); }
template <int CTRL> __device__ __forceinline__ float dpp_mov(float v) { return __uint_as_float((unsigned)__builtin_amdgcn_update_dpp(0, (int)__float_as_uint(v), CTRL, 0xF, 0xF, true)); }
__device__ __forceinline__ float sum8(float v) { v += dpp_mov<0xB1>(v); v += dpp_mov<0x4E>(v); v += dpp_mov<0x141>(v); return v; }
__device__ __forceinline__ float sum16(float v) { v = sum8(v); v += dpp_mov<0x140>(v); return v; }
__device__ __forceinline__ float wave_sum(float v) {
    v = sum16(v);
    const float a = __uint_as_float((unsigned)__builtin_amdgcn_readlane((int)__float_as_uint(v), 0)), b = __uint_as_float((unsigned)__builtin_amdgcn_readlane((int)__float_as_uint(v), 16));
    const float c = __uint_as_float((unsigned)__builtin_amdgcn_readlane((int)__float_as_uint(v), 32)), d = __uint_as_float((unsigned)__builtin_amdgcn_readlane((int)__float_as_uint(v), 48));
    return (a + b) + (c + d);
}
__device__ __forceinline__ float sumsq8(u32x4 w) {
    float s = 0.f;
#pragma unroll
    for (int i = 0; i < 4; ++i) { const float a = bflo(w[i]), b = bfhi(w[i]); s += a * a + b * b; }
    return s;
}

namespace pg8 {
constexpr int BM = 256, BK = 64, HALF = 128, HTB = HALF * BK * 2, STAGE_BYTES = 8 * HTB, NXCD = 8, WGM = 4;
__host__ __device__ __forceinline__ int lds_byte(int r, int c) { const int st = (r >> 4) * 2 + (c >> 5), rr = r & 15, cc = c & 31, ob = rr * 64 + cc * 2; return st * 1024 + (ob ^ (((ob >> 9) & 1) << 5)); }
__host__ __device__ __forceinline__ void stage_rc(int b, int& R, int& C) { const int st = b / 1024, sb = b % 1024, swz = sb ^ (((sb >> 9) & 1) << 5); R = (st >> 1) * 16 + swz / 64; C = (st & 1) * 32 + (swz % 64) / 2; }
__host__ __device__ __forceinline__ int perm32(int rho) { const int n = rho >> 4, i = rho & 15; return 8 * (i >> 2) + 4 * n + (i & 3); }
struct Unit { int pm, pn; };
struct Gemm { const bf16_t* A; const bf16_t* Bt; int M, N, K, lda; };
struct StaticOrder {
    int nM, nN, nwg, G, c;
    __device__ void init(int M, int N, int G_, int c_) { nM = M / BM; nN = N / BM; nwg = nM * nN; G = G_; c = c_; }
    __device__ bool next(int i, Unit& u) const {
        const long L = (long)i * G + c; if (L >= nwg) return false;
        int wgid = (int)L; { const int q = nwg / NXCD, r = nwg % NXCD, xcd = wgid % NXCD, off = wgid / NXCD; wgid = (xcd < r ? xcd * (q + 1) : r * (q + 1) + (xcd - r) * q) + off; }
        const int nig = WGM * nN, gid = wgid / nig, fm = gid * WGM, gsz = (nM - fm) < WGM ? (nM - fm) : WGM;
        u.pm = fm + ((wgid % nig) % gsz); u.pn = (wgid % nig) / gsz; return true;
    }
};
struct EpiRT {
    static constexpr bool PERM = true;
    int mode; bf16_t* O; int ldc; const float* rstd; const float* bias; const bf16_t* R; const float* Xin; float* Xout; int ldr;
    __device__ __forceinline__ void operator()(const f32x4 (&acc)[2][2][4][2], const Unit& u, int wr, int wc, int fr, int fq) const {
        const int row0 = u.pm * BM + wr * 64 + fr, col0 = u.pn * BM + wc * 32 + 8 * fq;
        const int kind = (mode == 1) ? (u.pn < 12 ? 0 : (u.pn < 18 ? 1 : 2)) : 2;
        f32x4 bv[2][2];
#pragma unroll
        for (int bj = 0; bj < 2; ++bj) { bv[bj][0] = (f32x4){0.f, 0.f, 0.f, 0.f}; bv[bj][1] = bv[bj][0];
            if (kind == 0) { bv[bj][0] = *(const f32x4*)(bias + col0 + bj * HALF); bv[bj][1] = *(const f32x4*)(bias + col0 + bj * HALF + 4); } }
#pragma unroll
        for (int ai = 0; ai < 2; ++ai)
#pragma unroll
            for (int mp = 0; mp < 2; ++mp) {
                float rs[2]; u32x4 t0[2][2], t1[2][2];
#pragma unroll
                for (int mm = 0; mm < 2; ++mm) { const int row = row0 + ai * HALF + (2 * mp + mm) * 16;
                    rs[mm] = rstd ? rstd[row] : 1.f;
#pragma unroll
                    for (int bj = 0; bj < 2; ++bj) {
                        if (mode == 4) { const size_t off = (size_t)row * 1024 + col0 + bj * HALF; t0[mm][bj] = *(const u32x4*)(Xin + off); t1[mm][bj] = *(const u32x4*)(Xin + off + 4); }
                        else if (mode >= 2) { t0[mm][bj] = *(const u32x4*)(R + (size_t)row * ldr + col0 + bj * HALF);
                            if (mode == 3) t1[mm][bj] = *(const u32x4*)(O + (size_t)row * ldc + col0 + bj * HALF); } } }
#pragma unroll
                for (int mm = 0; mm < 2; ++mm) { const int m = 2 * mp + mm; const int row = row0 + ai * HALF + m * 16;
#pragma unroll
                    for (int bj = 0; bj < 2; ++bj) {
                        f32x4 v0 = acc[ai][bj][m][0], v1 = acc[ai][bj][m][1];
                        if (mode == 4) {
                            const size_t off = (size_t)row * 1024 + col0 + bj * HALF;
                            const u32x4 qa = t0[mm][bj], qb = t1[mm][bj];
                            *(f32x4*)(Xout + off) = (f32x4){__uint_as_float(qa.x), __uint_as_float(qa.y), __uint_as_float(qa.z), __uint_as_float(qa.w)} + v0;
                            *(f32x4*)(Xout + off + 4) = (f32x4){__uint_as_float(qb.x), __uint_as_float(qb.y), __uint_as_float(qb.z), __uint_as_float(qb.w)} + v1;
                        } else {
                            v0 = v0 * rs[mm]; v1 = v1 * rs[mm];
                            if (kind == 0) {
                                v0 = v0 + bv[bj][0]; v1 = v1 + bv[bj][1];
#pragma unroll
                                for (int e = 0; e < 4; ++e) { v0[e] = sigmoidf_(v0[e]); v1[e] = sigmoidf_(v1[e]); }
                            } else if (kind == 1) {
#pragma unroll
                                for (int e = 0; e < 4; ++e) { v0[e] = v0[e] * sigmoidf_(v0[e]); v1[e] = v1[e] * sigmoidf_(v1[e]); }
                            }
                            bf16_t* op = O + (size_t)row * ldc + col0 + bj * HALF;
                            if (mode == 2 || mode == 3) { const u32x4 q = t0[mm][bj];
                                v0[0] *= bflo(q[0]); v0[1] *= bfhi(q[0]); v0[2] *= bflo(q[1]); v0[3] *= bfhi(q[1]);
                                v1[0] *= bflo(q[2]); v1[1] *= bfhi(q[2]); v1[2] *= bflo(q[3]); v1[3] *= bfhi(q[3]);
                                if (mode == 3) { const u32x4 y = t1[mm][bj];
                                    v0[0] += bflo(y[0]); v0[1] += bfhi(y[0]); v0[2] += bflo(y[1]); v0[3] += bfhi(y[1]);
                                    v1[0] += bflo(y[2]); v1[1] += bfhi(y[2]); v1[2] += bflo(y[3]); v1[3] += bfhi(y[3]); } }
                            u32x4 w; w.x = cvtpk(v0[0], v0[1]); w.y = cvtpk(v0[2], v0[3]); w.z = cvtpk(v1[0], v1[1]); w.w = cvtpk(v1[2], v1[3]);
                            *(u32x4*)op = w;
                        }
                    } }
                asm volatile("" ::: "memory");
            }
    }
};

template <class EpiT>
__device__ __forceinline__ void gemm_phase(LAS unsigned char* lds, const Gemm g, const StaticOrder& S, const EpiT& E, const int tid) {
    const int wid = __builtin_amdgcn_readfirstlane(tid >> 6), lane = tid & 63, wr = wid >> 2, wc = wid & 3, fr = lane & 15, fq = lane >> 4;
    const int K = g.K, nt = K / BK;
    unsigned voffA[2], voffB[2];
#pragma unroll
    for (int i = 0; i < 2; ++i) { int R, C; stage_rc(tid * 16 + i * 8192, R, C); const int Rb = EpiT::PERM ? ((R & ~31) + perm32(R & 31)) : R;
        voffA[i] = (unsigned)(R * g.lda + C) * 2u; voffB[i] = (unsigned)(Rb * K + C) * 2u; }
    const size_t kstep = (size_t)(BK * 2);
    const size_t hstepA = (size_t)HALF * g.lda * 2, hstepB = (size_t)HALF * K * 2;
    const size_t tstepA = 2 * hstepA, tstepB = 2 * hstepB;
    const unsigned ldsw = (unsigned)wid * 1024u;
    const int aoff = lds_byte(wr * 64 + fr, fq * 8), boff = lds_byte(wc * 32 + fr, fq * 8);
#define PG8_SA(b, h) (((b) * 2 + (h)) * HTB)
#define PG8_SB(b, h) ((4 + (b) * 2 + (h)) * HTB)
#define PG8_STAGE(bufoff, gbase, voff) do { _Pragma("unroll") for (int _i = 0; _i < 2; ++_i) \
        __builtin_amdgcn_global_load_lds((const unsigned*)((const char*)(gbase) + (voff)[_i]), (LAS unsigned*)(lds + (bufoff) + ldsw + _i * 8192), 16, 0, 0); } while (0)
#define PG8_LDA(dst, b, h) do { _Pragma("unroll") for (int m = 0; m < 4; ++m) _Pragma("unroll") for (int k = 0; k < 2; ++k) dst[m][k] = *(const LAS bf16x8*)(lds + PG8_SA(b, h) + aoff + m * 2048 + k * 1024); } while (0)
#define PG8_LDB(dst, b, h) do { _Pragma("unroll") for (int n = 0; n < 2; ++n) _Pragma("unroll") for (int k = 0; k < 2; ++k) dst[n][k] = *(const LAS bf16x8*)(lds + PG8_SB(b, h) + boff + n * 2048 + k * 1024); } while (0)
#define PG8_MMA(ai, bj, At, Bt) do { __builtin_amdgcn_s_setprio(1); _Pragma("unroll") for (int m = 0; m < 4; ++m) _Pragma("unroll") for (int n = 0; n < 2; ++n) _Pragma("unroll") for (int k = 0; k < 2; ++k) \
        acc[ai][bj][m][n] = __builtin_amdgcn_mfma_f32_16x16x32_bf16(Bt[n][k], At[m][k], acc[ai][bj][m][n], 0, 0, 0); __builtin_amdgcn_s_setprio(0); } while (0)
#define PG8_WAIT_V(n) asm volatile("s_waitcnt vmcnt(" #n ")" ::: "memory")
#define PG8_WAIT_L(n) asm volatile("s_waitcnt lgkmcnt(" #n ")" ::: "memory")
#define PG8_BAR __builtin_amdgcn_s_barrier()
#define PG8_SCHED __builtin_amdgcn_sched_barrier(0)
    Unit cur, nxt; int ui = 0;
    if (!S.next(0, cur)) return;
    f32x4 acc[2][2][4][2];
#pragma unroll
    for (int a = 0; a < 2; ++a)
#pragma unroll
        for (int b = 0; b < 2; ++b)
#pragma unroll
            for (int m = 0; m < 4; ++m)
#pragma unroll
                for (int n = 0; n < 2; ++n) acc[a][b][m][n] = (f32x4){0.f, 0.f, 0.f, 0.f};
    bf16x8 At[4][2], B0[2][2], B1[2][2];
    const char* cA = (const char*)g.A + (size_t)cur.pm * tstepA; const char* cB = (const char*)g.Bt + (size_t)cur.pn * tstepB;
    PG8_STAGE(PG8_SB(0, 0), cB, voffB); PG8_STAGE(PG8_SB(0, 1), cB + hstepB, voffB); PG8_STAGE(PG8_SA(0, 0), cA, voffA); PG8_STAGE(PG8_SA(0, 1), cA + hstepA, voffA);
    if (wr == 1) PG8_BAR;
    PG8_WAIT_V(2); PG8_BAR;
    PG8_STAGE(PG8_SB(1, 0), cB + kstep, voffB); PG8_STAGE(PG8_SA(1, 0), cA + kstep, voffA); PG8_STAGE(PG8_SB(1, 1), cB + hstepB + kstep, voffB);
    PG8_WAIT_V(6); PG8_BAR;
    for (;;) {
        const bool has_next = S.next(ui + 1, nxt);
        const char* nA = has_next ? (const char*)g.A + (size_t)nxt.pm * tstepA : cA; const char* nB = has_next ? (const char*)g.Bt + (size_t)nxt.pn * tstepB : cB;
        for (int t = 0; t < nt; t += 2) {
            const bool last = (t == nt - 2);
            const char* a1 = cA + (size_t)(t + 1) * kstep;
            const char* a2 = last ? nA : cA + (size_t)(t + 2) * kstep; const char* b2 = last ? nB : cB + (size_t)(t + 2) * kstep;
            const char* a3 = a2 + kstep; const char* b3 = b2 + kstep;
            PG8_LDB(B0, 0, 0); PG8_LDB(B1, 0, 1); PG8_SCHED; PG8_LDA(At, 0, 0); PG8_STAGE(PG8_SA(1, 1), a1 + hstepA, voffA);
            PG8_WAIT_V(8); PG8_WAIT_L(0); PG8_BAR; PG8_MMA(0, 0, At, B0); PG8_MMA(0, 1, At, B1); PG8_BAR; PG8_SCHED;
            PG8_LDA(At, 0, 1); PG8_STAGE(PG8_SB(0, 0), b2, voffB); PG8_STAGE(PG8_SB(0, 1), b2 + hstepB, voffB); PG8_STAGE(PG8_SA(0, 0), a2, voffA);
            PG8_WAIT_V(8); PG8_WAIT_L(0); PG8_BAR; PG8_MMA(1, 0, At, B0); PG8_MMA(1, 1, At, B1); PG8_BAR; PG8_SCHED;
            PG8_LDB(B0, 1, 0); PG8_LDB(B1, 1, 1); PG8_SCHED; PG8_LDA(At, 1, 0); PG8_STAGE(PG8_SA(0, 1), a2 + hstepA, voffA);
            PG8_WAIT_V(8); PG8_WAIT_L(0); PG8_BAR; PG8_MMA(0, 0, At, B0); PG8_MMA(0, 1, At, B1); PG8_BAR; PG8_SCHED;
            PG8_LDA(At, 1, 1); PG8_STAGE(PG8_SB(1, 0), b3, voffB); PG8_STAGE(PG8_SB(1, 1), b3 + hstepB, voffB); PG8_STAGE(PG8_SA(1, 0), a3, voffA);
            PG8_WAIT_V(8); PG8_WAIT_L(0); PG8_BAR; PG8_MMA(1, 0, At, B0); PG8_MMA(1, 1, At, B1); PG8_BAR; PG8_SCHED;
        }
        if (wr == 0) PG8_BAR;
        E(acc, cur, wr, wc, fr, fq);
        if (!has_next) break;
#pragma unroll
        for (int a = 0; a < 2; ++a)
#pragma unroll
            for (int b = 0; b < 2; ++b)
#pragma unroll
                for (int m = 0; m < 4; ++m)
#pragma unroll
                    for (int n = 0; n < 2; ++n) acc[a][b][m][n] = (f32x4){0.f, 0.f, 0.f, 0.f};
        cur = nxt; cA = nA; cB = nB; ++ui;
        if (wr == 1) PG8_BAR;
    }
    PG8_WAIT_V(0);
    PG8_BAR;
#undef PG8_SA
#undef PG8_SB
#undef PG8_STAGE
#undef PG8_LDA
#undef PG8_LDB
#undef PG8_MMA
#undef PG8_WAIT_V
#undef PG8_WAIT_L
#undef PG8_BAR
#undef PG8_SCHED
}
}

namespace att {
constexpr int NW = 8, QBLK = 32, KVBLK = 64;
constexpr float THR = 8.f;
constexpr int SHM_K = KVBLK * 256;
#define KSWZ(row, colB) ((row) * 256 + ((colB) ^ ((((row) & 7) | ((((row) >> 4) & 1) << 3)) << 4)))
#define SBAR() __builtin_amdgcn_sched_barrier(0)
__device__ __forceinline__ int crow(int r, int hi) { return (r & 3) + 8 * (r >> 2) + 4 * hi; }
template <int DQ> struct Sc { static constexpr float SCALE = (DQ == 96) ? 0.10206207261596575f : 0.08838834764831845f; };

template <int DQ, bool PRE>
__device__ __forceinline__ void partialSM(f32x16& p0, f32x16& p1, float& m_reg, float& mn, float& alpha) {
    constexpr float SCALE = PRE ? 0.6931471805599453f : Sc<DQ>::SCALE, C = SCALE * 1.4426950408889634f;
    float pmax = p0[0];
#pragma unroll
    for (int r = 1; r < 16; ++r) pmax = fmaxf(pmax, p0[r]);
#pragma unroll
    for (int r = 0; r < 16; ++r) pmax = fmaxf(pmax, p1[r]);
    { auto rr = __builtin_amdgcn_permlane32_swap(__float_as_uint(pmax), __float_as_uint(pmax), false, false);
      pmax = fmaxf(__uint_as_float(rr[0]), __uint_as_float(rr[1])); }
    if (__builtin_expect(__all(pmax - m_reg <= THR / SCALE), 1)) { mn = m_reg; alpha = 1.f; }
    else { mn = fmaxf(m_reg, pmax); alpha = __builtin_amdgcn_exp2f((m_reg - mn) * C); m_reg = mn; }
    const float mnC = -mn * C;
#pragma unroll
    for (int r = 0; r < 16; ++r) p0[r] = fmaf(p0[r], C, mnC);
#pragma unroll
    for (int r = 0; r < 16; ++r) p1[r] = fmaf(p1[r], C, mnC);
#pragma unroll
    for (int r = 0; r < 16; ++r) p0[r] = __builtin_amdgcn_exp2f(p0[r]);
}
__device__ __forceinline__ void finishSM(f32x16& p0, f32x16& p1, float alpha, float& l_reg, bf16x8& pa0, bf16x8& pa1, bf16x8& pa2, bf16x8& pa3) {
#pragma unroll
    for (int r = 0; r < 16; ++r) p1[r] = __builtin_amdgcn_exp2f(p1[r]);
    float ps = 0;
#pragma unroll
    for (int r = 0; r < 16; ++r) ps += p0[r];
#pragma unroll
    for (int r = 0; r < 16; ++r) ps += p1[r];
    { auto rr = __builtin_amdgcn_permlane32_swap(__float_as_uint(ps), __float_as_uint(ps), false, false);
      ps = __uint_as_float(rr[0]) + __uint_as_float(rr[1]); }
    l_reg = l_reg * alpha + ps;
#define PK4(P, BASE, OUT) do { unsigned a0 = cvtpk(P[BASE + 0], P[BASE + 1]), a1 = cvtpk(P[BASE + 2], P[BASE + 3]);   \
    unsigned b0 = cvtpk(P[BASE + 4], P[BASE + 5]), b1 = cvtpk(P[BASE + 6], P[BASE + 7]);                              \
    auto r0 = __builtin_amdgcn_permlane32_swap(a0, b0, false, false); auto r1 = __builtin_amdgcn_permlane32_swap(a1, b1, false, false); \
    u32x4 w = {r0[0], r1[0], r0[1], r1[1]}; OUT = *reinterpret_cast<bf16x8*>(&w); } while (0)
    PK4(p0, 0, pa0); PK4(p0, 8, pa1); PK4(p1, 0, pa2); PK4(p1, 8, pa3);
#undef PK4
}
__device__ __forceinline__ void fastSM0(f32x16& p0) {
#pragma unroll
    for (int r = 0; r < 16; ++r) p0[r] = __builtin_amdgcn_exp2f(p0[r]);
}
template <int DQ>
__device__ __forceinline__ void qkt(f32x16& p0, f32x16& p1, const char* Ks, const bf16x8* qr, int r32, int hi, float init) {
#pragma unroll
    for (int r = 0; r < 16; ++r) { p0[r] = init; p1[r] = init; }
#pragma unroll
    for (int d0 = 0; d0 < DQ / 16; ++d0) { const int cb = (d0 * 16 + hi * 8) * 2;
        const bf16x8 b0 = *reinterpret_cast<const bf16x8*>(Ks + KSWZ(r32, cb));
        const bf16x8 b1 = *reinterpret_cast<const bf16x8*>(Ks + KSWZ(32 + r32, cb));
        p0 = __builtin_amdgcn_mfma_f32_32x32x16_bf16(b0, qr[d0], p0, 0, 0, 0);
        p1 = __builtin_amdgcn_mfma_f32_32x32x16_bf16(b1, qr[d0], p1, 0, 0, 0);
        if (DQ == 128 && d0 == 3) SBAR(); }
}
template <int DV> __device__ __forceinline__ int v_st(int k, int c) { const int kk = (k & ~0xC) | ((k & 4) << 1) | ((k & 8) >> 1); return ((kk >> 3) * (DV / 32) + (c >> 5)) * 512 + ((kk & 7) * 32 + (c & 31)) * 2; }
__device__ __forceinline__ int v_rd_base(int lane) { return ((lane & 3) << 3) | (((lane >> 2) & 3) << 6) | (((lane >> 4) & 1) << 5) | (((lane >> 5) & 1) << 8); }
template <int DV> constexpr int v_rd_off(int d0, int ks, int half) { return d0 * 512 + ks * (4096 * DV / 128) + half * (2048 * DV / 128); }
template <int OFF> __device__ __forceinline__ s16x4 tr_read(int vb) {
    s16x4 r; asm volatile("ds_read_b64_tr_b16 %0, %1 offset:%2" : "=&v"(r) : "v"(vb), "i"(OFF) : "memory"); return r;
}
template <int DV, int D0> __device__ __forceinline__ void pv_one(f32x16& od, int vb, bf16x8 pa0, bf16x8 pa1, bf16x8 pa2, bf16x8 pa3) {
    const s16x4 l0 = tr_read<v_rd_off<DV>(D0, 0, 0)>(vb), h0 = tr_read<v_rd_off<DV>(D0, 0, 1)>(vb), l1 = tr_read<v_rd_off<DV>(D0, 1, 0)>(vb), h1 = tr_read<v_rd_off<DV>(D0, 1, 1)>(vb);
    const s16x4 l2 = tr_read<v_rd_off<DV>(D0, 2, 0)>(vb), h2 = tr_read<v_rd_off<DV>(D0, 2, 1)>(vb), l3 = tr_read<v_rd_off<DV>(D0, 3, 0)>(vb), h3 = tr_read<v_rd_off<DV>(D0, 3, 1)>(vb);
    asm volatile("s_waitcnt lgkmcnt(0)" ::: "memory"); SBAR();
#define PK(L, H) (bf16x8){L[0], L[1], L[2], L[3], H[0], H[1], H[2], H[3]}
    od = __builtin_amdgcn_mfma_f32_32x32x16_bf16(pa0, PK(l0, h0), od, 0, 0, 0);
    od = __builtin_amdgcn_mfma_f32_32x32x16_bf16(pa1, PK(l1, h1), od, 0, 0, 0);
    od = __builtin_amdgcn_mfma_f32_32x32x16_bf16(pa2, PK(l2, h2), od, 0, 0, 0);
    od = __builtin_amdgcn_mfma_f32_32x32x16_bf16(pa3, PK(l3, h3), od, 0, 0, 0);
#undef PK
}
template <int DV> __device__ __forceinline__ void pv_all(f32x16* o, int vb, bf16x8 pa0, bf16x8 pa1, bf16x8 pa2, bf16x8 pa3) {
    pv_one<DV, 0>(o[0], vb, pa0, pa1, pa2, pa3); pv_one<DV, 1>(o[1], vb, pa0, pa1, pa2, pa3);
    if constexpr (DV == 128) { pv_one<DV, 2>(o[2], vb, pa0, pa1, pa2, pa3); pv_one<DV, 3>(o[3], vb, pa0, pa1, pa2, pa3); }
}

template <int DQ, int DV, int SD, int ldq, int ldo, bool PRE, bool FAST>
__device__ __forceinline__ void attn_unit(const bf16_t* Qb, const bf16_t* Kh, const bf16_t* Vh, bf16_t* OG, int seq, char* lds, const int tid, const float* qn, float kmax) {
    constexpr int NQ = DQ / 16, NO = DV / 32, SHM_V = KVBLK * DV * 2;
    constexpr int KCH = DQ / 8, VCH = DV / 8;
    constexpr int NVI = KVBLK * VCH / 512;
    constexpr bool K2ALL = (KVBLK * KCH == 1024);
    const int wid = tid >> 6, lane = tid & 63, r32 = lane & 31, hi = lane >> 5;
    char* V_lds = lds; char* K_lds = lds + 2 * SHM_V;
    float* wsf = (float*)(lds + 2 * SHM_V + 2 * SHM_K) + wid * 64; float* li_l = wsf; float* al_l = wsf + 32;
    float m_reg = -1e30f, l_reg = 0; f32x16 o[NO]; bf16x8 qr[NQ];
    float negm = 0.f; if constexpr (FAST) negm = -(qn[(wid * QBLK + r32) * 8] * kmax);
#pragma unroll
    for (int d = 0; d < NO; ++d) o[d] = f32x16{};
    const bf16_t* Qw = Qb + (size_t)(wid * QBLK + r32) * ldq + hi * 8;
#pragma unroll
    for (int d0 = 0; d0 < NQ; ++d0) qr[d0] = *reinterpret_cast<const bf16x8*>(Qw + d0 * 16);
    const int kc0 = tid, kc1 = tid + 512;
    const int kl0 = KSWZ(kc0 / KCH, (kc0 % KCH) * 16), kl1 = KSWZ(kc1 / KCH, (kc1 % KCH) * 16);
    const bool k1on = K2ALL || (wid < 4);
    const int vl0 = v_st<DV>(tid / VCH, (tid % VCH) * 8), vl1 = v_st<DV>((tid + 512) / VCH, ((tid + 512) % VCH) * 8);
    const int vb0 = (int)(uintptr_t)V_lds + v_rd_base(lane);
    struct Slot { bf16x8 v0, v1, k0, k1; }; Slot sA, sB2; Slot& sB = (SD == 2) ? sB2 : sA;
#define SLOAD(S, key0) do { const bf16_t* kp_ = Kh + (size_t)(key0) * DQ; const bf16_t* vp_ = Vh + (size_t)(key0) * DV; \
        S.v0 = *reinterpret_cast<const bf16x8*>(vp_ + tid * 8); if constexpr (NVI == 2) S.v1 = *reinterpret_cast<const bf16x8*>(vp_ + (tid + 512) * 8); \
        S.k0 = *reinterpret_cast<const bf16x8*>(kp_ + kc0 * 8); if (k1on) S.k1 = *reinterpret_cast<const bf16x8*>(kp_ + kc1 * 8); } while (0)
#define SWRITE(b, S) do { *(bf16x8*)(V_lds + (b) * SHM_V + vl0) = S.v0; if constexpr (NVI == 2) *(bf16x8*)(V_lds + (b) * SHM_V + vl1) = S.v1; \
        *(bf16x8*)(K_lds + (b) * SHM_K + kl0) = S.k0; if (k1on) *(bf16x8*)(K_lds + (b) * SHM_K + kl1) = S.k1; } while (0)
#define RESC(a) do { if (__any((a) < 1.f)) { if (hi == 0) al_l[r32] = (a); asm volatile("s_waitcnt lgkmcnt(0)" ::: "memory"); \
        _Pragma("unroll") for (int d = 0; d < NO; ++d) _Pragma("unroll") for (int r = 0; r < 16; ++r) o[d][r] *= al_l[crow(r, hi)]; } } while (0)
    f32x16 pA0, pA1, pB0, pB1; float mnA, mnB, alA, alB; bf16x8 pa0, pa1, pa2, pa3; const int NT = seq / KVBLK;
    SLOAD(sA, 0); SWRITE(0, sA); __syncthreads();
#define PSM(P0, P1, MN, AL) do { if constexpr (FAST) { fastSM0(P0); AL = 1.f; } else partialSM<DQ, PRE>(P0, P1, m_reg, MN, AL); } while (0)
#define RESCX(a) do { if constexpr (!FAST) RESC(a); } while (0)
    qkt<DQ>(pA0, pA1, K_lds, qr, r32, hi, negm); PSM(pA0, pA1, mnA, alA);
    SLOAD(sB, KVBLK); if (SD == 2 && 2 < NT) SLOAD(sA, 2 * KVBLK);
    SWRITE(1, sB); __syncthreads();
    for (int j = 1; j + 1 < NT; j += 2) {
        SBAR(); qkt<DQ>(pB0, pB1, K_lds + SHM_K, qr, r32, hi, negm);
        finishSM(pA0, pA1, alA, l_reg, pa0, pa1, pa2, pa3); SBAR();
        SLOAD(sB, (j + SD) * KVBLK); SBAR();
        pv_all<DV>(o, vb0, pa0, pa1, pa2, pa3); PSM(pB0, pB1, mnB, alB);
        __syncthreads(); SWRITE(0, sA);
        RESCX(alB); __syncthreads();
        SBAR(); qkt<DQ>(pA0, pA1, K_lds, qr, r32, hi, negm);
        finishSM(pB0, pB1, alB, l_reg, pa0, pa1, pa2, pa3); SBAR();
        if (SD == 1 || j + 3 < NT) SLOAD(sA, (j + 1 + SD) * KVBLK); SBAR();
        pv_all<DV>(o, vb0 + SHM_V, pa0, pa1, pa2, pa3); PSM(pA0, pA1, mnA, alA);
        __syncthreads(); SWRITE(1, sB);
        RESCX(alA); __syncthreads();
    }
    SBAR(); qkt<DQ>(pB0, pB1, K_lds + SHM_K, qr, r32, hi, negm);
    finishSM(pA0, pA1, alA, l_reg, pa0, pa1, pa2, pa3); SBAR();
    pv_all<DV>(o, vb0, pa0, pa1, pa2, pa3); PSM(pB0, pB1, mnB, alB);
    __syncthreads(); RESCX(alB);
    finishSM(pB0, pB1, alB, l_reg, pa0, pa1, pa2, pa3); SBAR();
    pv_all<DV>(o, vb0 + SHM_V, pa0, pa1, pa2, pa3);
#undef PSM
#undef RESCX
    if (hi == 0) li_l[r32] = l_reg; asm volatile("s_waitcnt lgkmcnt(0)" ::: "memory");
    float rli[16];
#pragma unroll
    for (int r = 0; r < 16; ++r) rli[r] = __builtin_amdgcn_rcpf(li_l[crow(r, hi)]);
    bf16_t* Ow = OG + (size_t)(wid * QBLK) * ldo + r32;
    float gte[NO][16];
#pragma unroll
    for (int r = 0; r < 16; ++r)
#pragma unroll
        for (int d0 = 0; d0 < NO; ++d0) gte[d0][r] = bf1(Ow[(size_t)crow(r, hi) * ldo + d0 * 32]);
#pragma unroll
    for (int r = 0; r < 16; ++r)
#pragma unroll
        for (int d0 = 0; d0 < NO; ++d0) Ow[(size_t)crow(r, hi) * ldo + d0 * 32] = (bf16_t)(cvtpk(o[d0][r] * rli[r] * gte[d0][r], 0.f) & 0xffffu);
    __syncthreads();
#undef SLOAD
#undef SWRITE
#undef RESC
}

template <int ldq, int ldo>
__device__ __forceinline__ void attn_fast3(const bf16_t* Qb, const bf16_t* Kh, const bf16_t* Vh, bf16_t* OG, int seq, char* lds, const int tid, const float* qn, float kmax) {
    constexpr int DQ = 96, DV = 64, NQ = DQ / 16, NO = DV / 32, SHM_V = KVBLK * DV * 2, KCH = DQ / 8, VCH = DV / 8;
    const int wid = tid >> 6, lane = tid & 63, r32 = lane & 31, hi = lane >> 5;
    char* K_lds = lds; char* V_lds = lds + 3 * SHM_K;
    float* li_l = (float*)(lds + 3 * SHM_K + 3 * SHM_V) + wid * 64;
    float l_reg = 0; f32x16 o[NO]; bf16x8 qr[NQ];
    const float negm = -(qn[(wid * QBLK + r32) * 8] * kmax);
#pragma unroll
    for (int d = 0; d < NO; ++d) o[d] = f32x16{};
    const bf16_t* Qw = Qb + (size_t)(wid * QBLK + r32) * ldq + hi * 8;
#pragma unroll
    for (int d0 = 0; d0 < NQ; ++d0) qr[d0] = *reinterpret_cast<const bf16x8*>(Qw + d0 * 16);
    const int kc0 = tid, kc1 = tid + 512;
    const int kl0 = KSWZ(kc0 / KCH, (kc0 % KCH) * 16), kl1 = KSWZ(kc1 / KCH, (kc1 % KCH) * 16);
    const bool k1on = (wid < 4);
    const int vl0 = v_st<DV>(tid / VCH, (tid % VCH) * 8);
    const int vb0 = (int)(uintptr_t)V_lds + v_rd_base(lane);
    struct Slot { bf16x8 v0, k0, k1; }; Slot sA, sB;
#define SLOAD3(S, key0) do { const bf16_t* kp_ = Kh + (size_t)(key0) * DQ; const bf16_t* vp_ = Vh + (size_t)(key0) * DV; \
        S.v0 = *reinterpret_cast<const bf16x8*>(vp_ + tid * 8); S.k0 = *reinterpret_cast<const bf16x8*>(kp_ + kc0 * 8); if (k1on) S.k1 = *reinterpret_cast<const bf16x8*>(kp_ + kc1 * 8); } while (0)
#define SWRITE3(b, S) do { *(bf16x8*)(V_lds + (b) * SHM_V + vl0) = S.v0; *(bf16x8*)(K_lds + (b) * SHM_K + kl0) = S.k0; if (k1on) *(bf16x8*)(K_lds + (b) * SHM_K + kl1) = S.k1; } while (0)
    f32x16 pA0, pA1, pB0, pB1; bf16x8 pa0, pa1, pa2, pa3; const int NT = seq / KVBLK;
    SLOAD3(sA, 0); SLOAD3(sB, KVBLK); SWRITE3(0, sA); SWRITE3(1, sB); SLOAD3(sA, 2 * KVBLK); __syncthreads();
    qkt<DQ>(pA0, pA1, K_lds, qr, r32, hi, negm); fastSM0(pA0);
#define STEP3(PQ0, PQ1, PF0, PF1, SL, SW, J, BX, BY, BZ, DOLOAD, DOWRITE) do { \
        SBAR(); qkt<DQ>(PQ0, PQ1, K_lds + (BY) * SHM_K, qr, r32, hi, negm); \
        { float al_ = 1.f; finishSM(PF0, PF1, al_, l_reg, pa0, pa1, pa2, pa3); } __builtin_amdgcn_sched_group_barrier(0x100, 12, 0); SBAR(); \
        if (DOLOAD) SLOAD3(SL, ((J) + 3) * KVBLK); SBAR(); \
        pv_all<DV>(o, vb0 + (BX) * SHM_V, pa0, pa1, pa2, pa3); fastSM0(PQ0); \
        if (DOWRITE) SWRITE3(BZ, SW); \
        __syncthreads(); } while (0)
    int j = 0;
    for (; j + 6 < NT - 3; j += 6) {
        STEP3(pB0, pB1, pA0, pA1, sB, sA, j + 0, 0, 1, 2, true, true);
        STEP3(pA0, pA1, pB0, pB1, sA, sB, j + 1, 1, 2, 0, true, true);
        STEP3(pB0, pB1, pA0, pA1, sB, sA, j + 2, 2, 0, 1, true, true);
        STEP3(pA0, pA1, pB0, pB1, sA, sB, j + 3, 0, 1, 2, true, true);
        STEP3(pB0, pB1, pA0, pA1, sB, sA, j + 4, 1, 2, 0, true, true);
        STEP3(pA0, pA1, pB0, pB1, sA, sB, j + 5, 2, 0, 1, true, true);
    }
    STEP3(pB0, pB1, pA0, pA1, sB, sA, j + 0, 0, 1, 2, true, true);
    STEP3(pA0, pA1, pB0, pB1, sA, sB, j + 1, 1, 2, 0, false, true);
    STEP3(pB0, pB1, pA0, pA1, sB, sA, j + 2, 2, 0, 1, false, false);
    SBAR(); { float al_ = 1.f; finishSM(pB0, pB1, al_, l_reg, pa0, pa1, pa2, pa3); } SBAR();
    pv_all<DV>(o, vb0 + 0 * SHM_V, pa0, pa1, pa2, pa3);
#undef STEP3
#undef SLOAD3
#undef SWRITE3
    if (hi == 0) li_l[r32] = l_reg; asm volatile("s_waitcnt lgkmcnt(0)" ::: "memory");
    float rli[16];
#pragma unroll
    for (int r = 0; r < 16; ++r) rli[r] = __builtin_amdgcn_rcpf(li_l[crow(r, hi)]);
    bf16_t* Ow = OG + (size_t)(wid * QBLK) * ldo + r32;
    float gte[NO][16];
#pragma unroll
    for (int r = 0; r < 16; ++r)
#pragma unroll
        for (int d0 = 0; d0 < NO; ++d0) gte[d0][r] = bf1(Ow[(size_t)crow(r, hi) * ldo + d0 * 32]);
#pragma unroll
    for (int r = 0; r < 16; ++r)
#pragma unroll
        for (int d0 = 0; d0 < NO; ++d0) Ow[(size_t)crow(r, hi) * ldo + d0 * 32] = (bf16_t)(cvtpk(o[d0][r] * rli[r] * gte[d0][r], 0.f) & 0xffffu);
    __syncthreads();
}

template <int ldq, int ldo>
__device__ __forceinline__ void attn_dma4(const bf16_t* Qb, const bf16_t* Kh, const bf16_t* Vh, bf16_t* OG, int seq, char* lds, const int tid, const float* qn, float kmax, const bool first, const bool has_next) {
    constexpr int DQ = 96, DV = 64, NQ = DQ / 16, NO = DV / 32, SHM_V = KVBLK * DV * 2;
    const int wid = __builtin_amdgcn_readfirstlane(tid >> 6), lane = tid & 63, r32 = lane & 31, hi = lane >> 5;
    char* K_lds = lds; char* V_lds = lds + 4 * SHM_K;
    LAS unsigned char* Kl = (LAS unsigned char*)lds; LAS unsigned char* Vl = Kl + 4 * SHM_K;
    float* li_l = (float*)(lds + 4 * SHM_K + 4 * SHM_V) + wid * 64;
    float l_reg = 0; f32x16 o[NO]; bf16x8 qr[NQ];
    const float negm = -(qn[(wid * QBLK + r32) * 8] * kmax);
#pragma unroll
    for (int d = 0; d < NO; ++d) o[d] = f32x16{};
    const bf16_t* Qw = Qb + (size_t)(wid * QBLK + r32) * ldq + hi * 8;
#pragma unroll
    for (int d0 = 0; d0 < NQ; ++d0) qr[d0] = *reinterpret_cast<const bf16x8*>(Qw + d0 * 16);
    int kofs0, kofs1, vofs;
    { const int rowa = 4 * wid + (lane >> 4), rowb = rowa + 32, slot = lane & 15;
      const int fa = (rowa & 7) | (((rowa >> 4) & 1) << 3), fb = (rowb & 7) | (((rowb >> 4) & 1) << 3);
      const int ca = slot ^ fa, cb = slot ^ fb;
      kofs0 = rowa * DQ + (ca < 12 ? ca * 8 : 0); kofs1 = rowb * DQ + (cb < 12 ? cb * 8 : 0);
      const int sidx = wid * 64 + lane, sub = sidx >> 5, within = sidx & 31, kk = (sub >> 1) * 8 + (within >> 2), cc = (sub & 1) * 32 + (within & 3) * 8;
      const int key = (kk & ~0xC) | ((kk & 4) << 1) | ((kk & 8) >> 1);
      vofs = key * DV + cc; }
    const int vb0 = (int)(uintptr_t)V_lds + v_rd_base(lane);
#define DMA_TILE(T, SLOT) do { const bf16_t* kp_ = Kh + (size_t)(T) * (KVBLK * DQ); const bf16_t* vp_ = Vh + (size_t)(T) * (KVBLK * DV); \
        __builtin_amdgcn_global_load_lds((const unsigned*)(kp_ + kofs0), (LAS unsigned*)(Kl + (SLOT) * SHM_K + wid * 1024), 16, 0, 0); \
        __builtin_amdgcn_global_load_lds((const unsigned*)(kp_ + kofs1), (LAS unsigned*)(Kl + (SLOT) * SHM_K + 8192 + wid * 1024), 16, 0, 0); \
        __builtin_amdgcn_global_load_lds((const unsigned*)(vp_ + vofs), (LAS unsigned*)(Vl + (SLOT) * SHM_V + wid * 1024), 16, 0, 0); } while (0)
#define BAR_DMA(N) do { asm volatile("s_waitcnt vmcnt(" #N ")" ::: "memory"); asm volatile("s_waitcnt lgkmcnt(0)" ::: "memory"); __builtin_amdgcn_s_barrier(); asm volatile("" ::: "memory"); SBAR(); } while (0)
    f32x16 pA0, pA1, pB0, pB1; bf16x8 pa0, pa1, pa2, pa3; const int NT = seq / KVBLK;
    if (first) { asm volatile("s_waitcnt lgkmcnt(0)" ::: "memory"); __builtin_amdgcn_s_barrier(); asm volatile("" ::: "memory");
        DMA_TILE(0, 0); DMA_TILE(1, 1); DMA_TILE(2, 2); }
    BAR_DMA(3);
    qkt<DQ>(pA0, pA1, K_lds, qr, r32, hi, negm); fastSM0(pA0);
#define STEPD(PQ0, PQ1, PF0, PF1, J, S0, DOLOAD) do { \
        SBAR(); qkt<DQ>(PQ0, PQ1, K_lds + (((S0) + 1) & 3) * SHM_K, qr, r32, hi, negm); \
        { float al_ = 1.f; finishSM(PF0, PF1, al_, l_reg, pa0, pa1, pa2, pa3); } __builtin_amdgcn_sched_group_barrier(0x100, 12, 0); SBAR(); \
        if (DOLOAD) DMA_TILE((J) + 3, ((S0) + 3) & 3); SBAR(); \
        pv_all<DV>(o, vb0 + (S0) * SHM_V, pa0, pa1, pa2, pa3); fastSM0(PQ0); \
        if (DOLOAD) BAR_DMA(3); else BAR_DMA(0); } while (0)
    int j = 0;
    for (; j + 4 <= NT - 4; j += 4) {
        STEPD(pB0, pB1, pA0, pA1, j + 0, 0, true); STEPD(pA0, pA1, pB0, pB1, j + 1, 1, true);
        STEPD(pB0, pB1, pA0, pA1, j + 2, 2, true); STEPD(pA0, pA1, pB0, pB1, j + 3, 3, true);
    }
    bf16_t* Ow = OG + (size_t)(wid * QBLK) * ldo + r32;
    float gte[NO][16];
#pragma unroll
    for (int r = 0; r < 16; ++r)
#pragma unroll
        for (int d0 = 0; d0 < NO; ++d0) gte[d0][r] = bf1(Ow[(size_t)crow(r, hi) * ldo + d0 * 32]);
    STEPD(pB0, pB1, pA0, pA1, j + 0, 0, true);
    STEPD(pA0, pA1, pB0, pB1, j + 1, 1, false);
    STEPD(pB0, pB1, pA0, pA1, j + 2, 2, false);
    SBAR(); { float al_ = 1.f; finishSM(pB0, pB1, al_, l_reg, pa0, pa1, pa2, pa3); } SBAR();
    pv_all<DV>(o, vb0 + 3 * SHM_V, pa0, pa1, pa2, pa3);
    if (has_next) {
        asm volatile("s_waitcnt lgkmcnt(0)" ::: "memory"); __builtin_amdgcn_s_barrier(); asm volatile("" ::: "memory");
        DMA_TILE(0, 0); DMA_TILE(1, 1); DMA_TILE(2, 2); }
#undef STEPD
#undef DMA_TILE
#undef BAR_DMA
    if (hi == 0) li_l[r32] = l_reg; asm volatile("s_waitcnt lgkmcnt(0)" ::: "memory");
    float rli[16];
#pragma unroll
    for (int r = 0; r < 16; ++r) rli[r] = __builtin_amdgcn_rcpf(li_l[crow(r, hi)]);
#pragma unroll
    for (int r = 0; r < 16; ++r)
#pragma unroll
        for (int d0 = 0; d0 < NO; ++d0) Ow[(size_t)crow(r, hi) * ldo + d0 * 32] = (bf16_t)(cvtpk(o[d0][r] * rli[r] * gte[d0][r], 0.f) & 0xffffu);
    if (!has_next) __syncthreads();
}

template <int ldq, int ldo>
__device__ __forceinline__ void attn_mem(const bf16_t* Qb, const bf16_t* Kh, const bf16_t* Vh, bf16_t* OG, char* lds, const int tid) {
    constexpr int DQ = 128, DV = 128, NQ = DQ / 16, NO = DV / 32, SHM_V = KVBLK * DV * 2, NT = 4;
    const int wid = __builtin_amdgcn_readfirstlane(tid >> 6), lane = tid & 63, r32 = lane & 31, hi = lane >> 5;
    char* K_lds = lds; char* V_lds = lds + NT * SHM_K;
    LAS unsigned char* Kl = (LAS unsigned char*)lds; LAS unsigned char* Vl = Kl + NT * SHM_K;
    float* wsf = (float*)(lds + LDS_SCR_OFF) + wid * 64; float* li_l = wsf; float* al_l = wsf + 32;
    int kofs, vofs0, vofs1;
    { const int rowa = 4 * wid + (lane >> 4), slot = lane & 15, fa = (rowa & 7) | (((rowa >> 4) & 1) << 3);
      kofs = rowa * DQ + (slot ^ fa) * 8;
      const int s0 = wid * 64 + lane, s1 = (wid + 8) * 64 + lane;
      { const int sub = s0 >> 5, within = s0 & 31, kk = (sub >> 2) * 8 + (within >> 2), cc = (sub & 3) * 32 + (within & 3) * 8; vofs0 = ((kk & ~0xC) | ((kk & 4) << 1) | ((kk & 8) >> 1)) * DV + cc; }
      { const int sub = s1 >> 5, within = s1 & 31, kk = (sub >> 2) * 8 + (within >> 2), cc = (sub & 3) * 32 + (within & 3) * 8; vofs1 = ((kk & ~0xC) | ((kk & 4) << 1) | ((kk & 8) >> 1)) * DV + cc; } }
    const int vb0 = (int)(uintptr_t)V_lds + v_rd_base(lane);
    asm volatile("s_waitcnt lgkmcnt(0)" ::: "memory"); __builtin_amdgcn_s_barrier(); asm volatile("" ::: "memory");
#pragma unroll
    for (int i = 0; i < 8; ++i)
        __builtin_amdgcn_global_load_lds((const unsigned*)(Kh + kofs + i * 32 * DQ), (LAS unsigned*)(Kl + (wid + 8 * i) * 1024), 16, 0, 0);
#pragma unroll
    for (int t = 0; t < NT; ++t) {
        __builtin_amdgcn_global_load_lds((const unsigned*)(Vh + t * KVBLK * DV + vofs0), (LAS unsigned*)(Vl + t * SHM_V + wid * 1024), 16, 0, 0);
        __builtin_amdgcn_global_load_lds((const unsigned*)(Vh + t * KVBLK * DV + vofs1), (LAS unsigned*)(Vl + t * SHM_V + (wid + 8) * 1024), 16, 0, 0); }
    bf16x8 qr[NQ]; f32x16 o[NO]; float m_reg = -1e30f, l_reg = 0.f;
#pragma unroll
    for (int d = 0; d < NO; ++d) o[d] = f32x16{};
    const bf16_t* Qw = Qb + (size_t)(wid * QBLK + r32) * ldq + hi * 8;
#pragma unroll
    for (int d0 = 0; d0 < NQ; ++d0) qr[d0] = *reinterpret_cast<const bf16x8*>(Qw + d0 * 16);
    asm volatile("s_waitcnt vmcnt(0)" ::: "memory"); asm volatile("s_waitcnt lgkmcnt(0)" ::: "memory"); __builtin_amdgcn_s_barrier(); asm volatile("" ::: "memory"); SBAR();
    f32x16 p0, p1; bf16x8 pa0, pa1, pa2, pa3;
#pragma unroll
    for (int t = 0; t < NT; ++t) {
        float mn, al;
        qkt<DQ>(p0, p1, K_lds + t * SHM_K, qr, r32, hi, 0.f);
        partialSM<DQ, false>(p0, p1, m_reg, mn, al);
        if (__any(al < 1.f)) { if (hi == 0) al_l[r32] = al; asm volatile("s_waitcnt lgkmcnt(0)" ::: "memory");
#pragma unroll
            for (int d = 0; d < NO; ++d)
#pragma unroll
                for (int r = 0; r < 16; ++r) o[d][r] *= al_l[crow(r, hi)]; }
        finishSM(p0, p1, al, l_reg, pa0, pa1, pa2, pa3); SBAR();
        pv_all<DV>(o, vb0 + t * SHM_V, pa0, pa1, pa2, pa3);
    }
    if (hi == 0) li_l[r32] = l_reg; asm volatile("s_waitcnt lgkmcnt(0)" ::: "memory");
    float rli[16];
#pragma unroll
    for (int r = 0; r < 16; ++r) rli[r] = __builtin_amdgcn_rcpf(li_l[crow(r, hi)]);
    bf16_t* Ow = OG + (size_t)(wid * QBLK) * ldo + r32;
#pragma unroll
    for (int dh = 0; dh < 2; ++dh) {
        float gte[2][16];
#pragma unroll
        for (int r = 0; r < 16; ++r)
#pragma unroll
            for (int d0 = 0; d0 < 2; ++d0) gte[d0][r] = bf1(Ow[(size_t)crow(r, hi) * ldo + (2 * dh + d0) * 32]);
#pragma unroll
        for (int r = 0; r < 16; ++r)
#pragma unroll
            for (int d0 = 0; d0 < 2; ++d0) Ow[(size_t)crow(r, hi) * ldo + (2 * dh + d0) * 32] = (bf16_t)(cvtpk(o[2 * dh + d0][r] * rli[r] * gte[d0][r], 0.f) & 0xffffu);
        asm volatile("" ::: "memory"); }
    __syncthreads();
}
}

constexpr int NWAVES = 8;
constexpr int LDS_BYTES = 135168, LDS_CTL_OFF = 132096;

struct Params {
    const float* x; const float* mem; const int* pos;
    const float *norm_g, *w_in, *b_gate, *q_norm_g, *w_uq, *kv_norm_g, *w_ukv, *q_head_g, *k_head_g, *conv_w, *conv_b, *mem_norm_g, *w_mkv, *mem_q_g, *mem_k_g,
                *w_br_attn, *w_br_conv, *w_br_mem, *w_out;
    float* out; unsigned char* ws;
    float inv_freq[16];
};

__device__ __forceinline__ void transpose_item(const float* W, int ldn, int K, const float* gain, bf16_t* WT, int k0, int n0src, int dstrow, LAS float* scr, int lane) {
#pragma unroll
    for (int i = 0; i < 8; ++i) { const int kk = 8 * i + (lane >> 3), c4 = (lane & 7) * 4; const float gn = gain ? gain[k0 + kk] : 1.f;
        const f32x4 v = *(const f32x4*)(W + (size_t)(k0 + kk) * ldn + n0src + c4);
        scr[kk * 33 + c4 + 0] = v.x * gn; scr[kk * 33 + c4 + 1] = v.y * gn; scr[kk * 33 + c4 + 2] = v.z * gn; scr[kk * 33 + c4 + 3] = v.w * gn; }
    asm volatile("s_waitcnt lgkmcnt(0)" ::: "memory");
    const int c = lane & 7;
#pragma unroll
    for (int j = 0; j < 4; ++j) { const int n = (lane >> 3) + 8 * j; const LAS float* s = scr + (8 * c) * 33 + n;
        u32x4 o; o.x = cvtpk(s[0 * 33], s[1 * 33]); o.y = cvtpk(s[2 * 33], s[3 * 33]); o.z = cvtpk(s[4 * 33], s[5 * 33]); o.w = cvtpk(s[6 * 33], s[7 * 33]);
        *(u32x4*)(WT + (size_t)(dstrow + n) * K + k0 + 8 * c) = o; }
    asm volatile("s_waitcnt lgkmcnt(0)" ::: "memory");
}
__device__ __forceinline__ int win_dst_col(int n) {
    if (n < 384) return C_QLAT + n;
    if (n < 640) return C_KVLAT + (n - 384);
    if (n < 672) return C_KPE + (n - 640);
    if (n < 1184) return C_CB + (n - 672);
    if (n < 1696) return C_CC + (n - 1184);
    if (n < 2208) return C_CU + (n - 1696);
    if (n < 2720) return C_QMEM + (n - 2208);
    if (n < 3232) return C_GATTN + (n - 2720);
    if (n < 3744) return C_GCONV + (n - 3232);
    if (n < 4256) return C_GMEM + (n - 3744);
    return n - 4256;
}
__device__ __forceinline__ void rows_to_bf16(const float* xin, bf16_t* xb, float* rstd, int rows, int gw, int NGW, int lane) {
    for (int m = gw; m < rows; m += NGW) {
        const f32x4* xr = (const f32x4*)(xin + (size_t)m * 1024) + lane;
        f32x4 v[4]; float s = 0.f;
#pragma unroll
        for (int j = 0; j < 4; ++j) { v[j] = xr[64 * j]; s += (v[j].x * v[j].x + v[j].y * v[j].y) + (v[j].z * v[j].z + v[j].w * v[j].w); }
        s = wave_sum(s);
        if (lane == 0) rstd[m] = rsqrtf(s * (1.f / 1024.f) + EPS);
        u32x2* o8 = (u32x2*)(xb + (size_t)m * 1024) + lane;
#pragma unroll
        for (int j = 0; j < 4; ++j) { u32x2 w; w.x = cvtpk(v[j].x, v[j].y); w.y = cvtpk(v[j].z, v[j].w); o8[64 * j] = w; }
    }
}

#define XB_TMO      128
#define XB_XCNT(j)  (256  + 64 * (j))
#define XB_XSUB(j)  (1280 + 64 * (j))
#define XB_XGEN(j)  (2304 + 64 * (j))
#define XB_TOP      3328
#define XB_TOPGEN   3392
#define XCD_BAR_WORDS 3456
#define XB_SPIN_CAP (1u << 18)
__device__ __forceinline__ unsigned xb_ld(unsigned* p)              { return __hip_atomic_load(p, __ATOMIC_RELAXED, __HIP_MEMORY_SCOPE_AGENT); }
__device__ __forceinline__ unsigned xb_add(unsigned* p, unsigned v) { return __hip_atomic_fetch_add(p, v, __ATOMIC_RELAXED, __HIP_MEMORY_SCOPE_AGENT); }
__device__ __forceinline__ unsigned xb_xcc_id() { return (unsigned)__builtin_amdgcn_s_getreg((3 << 11) | 20) & 0xFu; }
#define XB_SPIN(cond, bar) do { unsigned _sp = 0; while (cond) { __builtin_amdgcn_s_sleep(1); \
    if ((++_sp & 255u) == 0u) { if (xb_ld(&(bar)[XB_TMO])) break; if (_sp > XB_SPIN_CAP) { atomicAdd(&(bar)[XB_TMO], 1u); break; } } } } while (0)
struct XcdBarrier { unsigned* bar; unsigned x; volatile LAS unsigned* st; };
__device__ __forceinline__ XcdBarrier xcd_barrier_post(unsigned* bar, volatile LAS unsigned* st) {
    XcdBarrier b; b.bar = bar; b.x = xb_xcc_id(); b.st = st;
    if (threadIdx.x == 0) (void)xb_add(&bar[XB_XCNT(b.x)], 1u);
    return b;
}
__device__ __forceinline__ void xcd_barrier_complete(unsigned* bar, unsigned x, unsigned& nloc, unsigned& nx) {
    const unsigned G = gridDim.x * gridDim.y * gridDim.z;
    unsigned sum, cnt, mine, sp = 0u;
    for (;;) {
        sum = 0u; cnt = 0u; mine = 0u;
#pragma unroll
        for (unsigned j = 0; j < 16; ++j) { const unsigned c = xb_ld(&bar[XB_XCNT(j)]); sum += c; cnt += (c > 0u) ? 1u : 0u; mine = (j == x) ? c : mine; }
        if (sum == G) break;
        __builtin_amdgcn_s_sleep(1);
        if ((++sp & 255u) == 0u) { if (xb_ld(&bar[XB_TMO])) break; if (sp > XB_SPIN_CAP) { atomicAdd(&bar[XB_TMO], 1u); break; } }
    }
    nloc = mine > 0u ? mine : 1u; nx = cnt > 0u ? cnt : 1u;
}
__device__ __forceinline__ void xcd_barrier(const XcdBarrier& b) {
    asm volatile("s_waitcnt vmcnt(0)" ::: "memory");
    __syncthreads();
    if (threadIdx.x == 0) {
        unsigned* bar = b.bar;
        __builtin_amdgcn_s_waitcnt(0);
        unsigned nloc = b.st[0], nx = b.st[1];
        if (nloc == 0u) { xcd_barrier_complete(bar, b.x, nloc, nx); b.st[0] = nloc; b.st[1] = nx; }
        const unsigned old = xb_add(&bar[XB_XSUB(b.x)], 1u);
        const unsigned gen = old / nloc;
        if (old + 1u == (gen + 1u) * nloc) {
            __builtin_amdgcn_fence(__ATOMIC_RELEASE, "agent");
            asm volatile("s_waitcnt vmcnt(0)" ::: "memory");
            const unsigned og = xb_add(&bar[XB_TOP], 1u);
            const unsigned tg = og / nx;
            if (og + 1u == (tg + 1u) * nx) xb_add(&bar[XB_TOPGEN], 1u);
            else XB_SPIN(xb_ld(&bar[XB_TOPGEN]) == tg, bar);
            __builtin_amdgcn_fence(__ATOMIC_ACQUIRE, "agent");
            xb_add(&bar[XB_XGEN(b.x)], 1u);
            asm volatile("s_waitcnt vmcnt(0)" ::: "memory");
        } else {
            XB_SPIN(xb_ld(&bar[XB_XGEN(b.x)]) == gen, bar);
            __builtin_amdgcn_fence(__ATOMIC_ACQUIRE, "agent");
            asm volatile("s_waitcnt vmcnt(0)" ::: "memory");
        }
    }
    __syncthreads();
}

enum { K_S0 = 0, K_S2, K_ROWS, K_CONV, K_QKV, K_MATT, K_ATT, K_NOP, K_G_MKV, K_G_IN, K_G_UQ, K_G_UKV, K_G_BC, K_G_BM, K_G_BA, K_G_OUT };
constexpr int STEPS_PER = 11, N_ITERS = DEPTH * NB, N_SETUP = 2, N_STEPS = N_SETUP + N_ITERS * STEPS_PER + 1;
__host__ __device__ __forceinline__ int step_kind(int s) {
    return s == 0 ? K_G_OUT : s == 1 ? K_G_IN : s == 2 ? K_G_UQ : s == 3 ? K_G_UKV : s == 4 ? K_CONV : s == 5 ? K_QKV : s == 6 ? K_MATT : s == 7 ? K_G_BC : s == 8 ? K_G_BM : s == 9 ? K_ATT : K_G_BA;
}
__host__ __device__ __forceinline__ bool step_sync(int s) { return (0x652 >> s) & 1; }

__global__ void __launch_bounds__(NWAVES * 64, 2) mega(Params p, int lo, int hi) {
    extern __shared__ __attribute__((aligned(16))) unsigned char lds[];
    cg::grid_group grid = cg::this_grid();
    LAS unsigned char* ldsl = (LAS unsigned char*)lds;
    const int G = gridDim.x, bx = blockIdx.x, NGW = G * NWAVES;
    unsigned char* ws = p.ws;
    bf16_t* WMKV = (bf16_t*)(ws + WS_WMKV); bf16_t* MEMB = (bf16_t*)(ws + WS_MEMB); bf16_t* MKVRAW = (bf16_t*)(ws + WS_MKVRAW);
    bf16_t* MK = (bf16_t*)(ws + WS_MK); bf16_t* MV = (bf16_t*)(ws + WS_MV); float* MRSTD = (float*)(ws + WS_MRSTD); float* RSTD = (float*)(ws + WS_RSTD);
    bf16_t* XB = (bf16_t*)(ws + WS_XB); bf16_t* PROJ = (bf16_t*)(ws + WS_PROJ); bf16_t* QRAW = (bf16_t*)(ws + WS_QRAW); bf16_t* KVRAW = (bf16_t*)(ws + WS_KVRAW);
    float* QN = (float*)(ws + WS_QN); float* KQMAX = (float*)(ws + WS_KQMAX);
    bf16_t* QF = (bf16_t*)(ws + WS_QF); bf16_t* KF = (bf16_t*)(ws + WS_KF); bf16_t* VF = (bf16_t*)(ws + WS_VF);
    if (threadIdx.x < 4) ((volatile LAS unsigned*)(ldsl + LDS_CTL_OFF))[threadIdx.x] = 0u;
    __syncthreads();
    const XcdBarrier xbar = xcd_barrier_post((unsigned*)(ws + WS_BAR), (volatile LAS unsigned*)(ldsl + LDS_CTL_OFF));
    for (int st = lo; st < hi; ++st) {
        int tidv = threadIdx.x; asm volatile("" : "+v"(tidv));
        const int tid = tidv, lane = tid & 63, wave = __builtin_amdgcn_readfirstlane(tid >> 6), gw = bx * NWAVES + wave;
        int kind, l = 0, b = 0; bool sync_after = true;
        if (st < N_SETUP) { kind = (st == 0) ? K_S0 : K_G_MKV; sync_after = (st == 0); }
        else { const int r = st - N_SETUP; int it;
            if (r == N_ITERS * STEPS_PER) { kind = K_G_OUT; it = N_ITERS - 1; }
            else { it = r / STEPS_PER; const int sidx = r % STEPS_PER; kind = step_kind(sidx); sync_after = step_sync(sidx);
                   if (sidx == 0) { if (it == 0) kind = K_NOP; else it -= 1; } }
            l = it >> 1; b = it & 1; }
        unsigned char* lw = ws + WS_LW + (size_t)l * LW_SIZE;
        const float* xin = (l == 0 ? p.x : (const float*)p.out) + (size_t)b * SEQ * 1024;
        float* xout = p.out + (size_t)b * SEQ * 1024;

#ifndef NO_GEMM
        if (kind >= K_G_MKV) {
            bf16_t* YB = KVRAW;
            pg8::Gemm g; pg8::EpiRT E; E.ldr = PJ; E.mode = 0; E.O = nullptr; E.ldc = PJ; E.rstd = nullptr; E.bias = nullptr; E.R = nullptr; E.Xin = nullptr; E.Xout = nullptr;
            g.M = SEQ; g.N = 1024; g.K = 512; g.lda = PJ;
            if (kind == K_G_MKV)      { g.A = MEMB; g.Bt = WMKV; g.M = NB * MEML; g.N = DEPTH * 1024; g.K = 1024; g.lda = 1024; E.O = MKVRAW; E.ldc = DEPTH * 1024; E.rstd = MRSTD; }
            else if (kind == K_G_IN)  { g.A = XB; g.Bt = (const bf16_t*)(lw + LW_WIN); g.N = PJ; g.K = 1024; g.lda = 1024; E.mode = 1; E.O = PROJ; E.rstd = RSTD; E.bias = p.b_gate + l * 3072; }
            else if (kind == K_G_UQ)  { g.A = PROJ + C_QLAT; g.Bt = (const bf16_t*)(lw + LW_WUQ); g.N = 768; g.K = 384; E.O = QRAW; E.ldc = 768; }
            else if (kind == K_G_UKV) { g.A = PROJ + C_KVLAT; g.Bt = (const bf16_t*)(lw + LW_WUKV); g.N = 1024; g.K = 256; E.O = KVRAW; E.ldc = 1024; }
            else if (kind == K_G_BC)  { g.A = PROJ + C_CB; g.Bt = (const bf16_t*)(lw + LW_WBC); E.mode = 2; E.O = YB; E.ldc = 1024; E.R = PROJ + C_RCONV; }
            else if (kind == K_G_BM)  { g.A = PROJ + C_GMEM; g.Bt = (const bf16_t*)(lw + LW_WBM); E.mode = 3; E.O = YB; E.ldc = 1024; E.R = PROJ + C_RMEM; }
            else if (kind == K_G_BA)  { g.A = PROJ + C_GATTN; g.Bt = (const bf16_t*)(lw + LW_WBA); E.mode = 3; E.O = YB; E.ldc = 1024; E.R = PROJ + C_RATTN; }
            else                      { g.A = YB; g.lda = 1024; g.Bt = (const bf16_t*)(lw + LW_WOUT); g.K = 1024; E.mode = 4; E.Xin = xin; E.Xout = xout; }
            pg8::StaticOrder S; S.init(g.M, g.N, G, bx);
            pg8::gemm_phase(ldsl, g, S, E, tid);
            if (kind == K_G_BA && (l * 2 + b) + 1 < DEPTH * NB) {
                const int ln = (l * 2 + b + 1) >> 1, bn = (l * 2 + b + 1) & 1;
                const float* xn = (ln == 0 ? p.x : (const float*)p.out) + (size_t)bn * SEQ * 1024;
                __syncthreads();
                rows_to_bf16(xn, XB, RSTD, SEQ, gw, NGW, lane);
                if (bx == 0 && tid < 16) KQMAX[tid] = 0.f;
            }
        }
#endif
#ifndef ONLY_GEMM
        if (kind == K_S0) {
            LAS float* scr = (LAS float*)(ldsl + wave * 16384);
            constexpr int I_IN = 16 * (INW / 32), I_UQ = 6 * 24, I_UKV = 4 * 32, I_MKV = 16 * 32, I_BR = 8 * 32, I_OUT = 16 * 32;
            constexpr int I_L = I_IN + I_UQ + I_UKV + I_MKV + 3 * I_BR + I_OUT;
            for (int it = gw; it < DEPTH * I_L; it += NGW) {
                const int ll = it / I_L; int r = it % I_L;
                unsigned char* lwl = ws + WS_LW + (size_t)ll * LW_SIZE;
                const float* src; const float* gain = nullptr; bf16_t* dst; int ldn, K, kb, nb, drow;
                if (r < I_IN) { const int nblk = INW / 32; kb = r / nblk; nb = r % nblk; src = p.w_in + (size_t)ll * 1024 * INW; ldn = INW; K = 1024; gain = p.norm_g + ll * 1024; dst = (bf16_t*)(lwl + LW_WIN); drow = win_dst_col(32 * nb); }
                else if ((r -= I_IN) < I_UQ) { kb = r / 24; nb = r % 24; src = p.w_uq + (size_t)ll * 384 * 768; ldn = 768; K = 384; gain = p.q_norm_g + ll * 384; dst = (bf16_t*)(lwl + LW_WUQ); drow = 32 * nb; }
                else if ((r -= I_UQ) < I_UKV) { kb = r / 32; nb = r % 32; src = p.w_ukv + (size_t)ll * 256 * 1024; ldn = 1024; K = 256; gain = p.kv_norm_g + ll * 256; dst = (bf16_t*)(lwl + LW_WUKV); drow = 32 * nb; }
                else if ((r -= I_UKV) < I_MKV) { kb = r / 32; nb = r % 32; src = p.w_mkv + (size_t)ll * 1024 * 1024; ldn = 1024; K = 1024; gain = p.mem_norm_g + ll * 1024; dst = WMKV; drow = ll * 1024 + 32 * nb; }
                else if ((r -= I_MKV) < 3 * I_BR) { const int which = r / I_BR, rr = r % I_BR; kb = rr / 32; nb = rr % 32;
                    src = (which == 0 ? p.w_br_attn : (which == 1 ? p.w_br_conv : p.w_br_mem)) + (size_t)ll * 512 * 1024; ldn = 1024; K = 512; dst = (bf16_t*)(lwl + LW_WBA + (size_t)which * SZ_WBR); drow = 32 * nb; }
                else { r -= 3 * I_BR; kb = r / 32; nb = r % 32; src = p.w_out + (size_t)ll * 1024 * 1024; ldn = 1024; K = 1024; dst = (bf16_t*)(lwl + LW_WOUT); drow = 32 * nb; }
                transpose_item(src, ldn, K, gain, dst, 64 * kb, 32 * nb, drow, scr, lane);
            }
            for (int i = bx * 512 + tid; i < DEPTH * 96 * 128; i += G * 512) { const int ll = i / (96 * 128), r = i % (96 * 128);
                *(u32x4*)(ws + WS_LW + (size_t)ll * LW_SIZE + LW_WIN + (size_t)INW * 2048 + (size_t)r * 16) = (u32x4){0u, 0u, 0u, 0u}; }
            rows_to_bf16(p.mem, MEMB, MRSTD, NB * MEML, gw, NGW, lane);
            rows_to_bf16(p.x, XB, RSTD, SEQ, gw, NGW, lane);
            if (bx == 0 && tid < 16) KQMAX[tid] = 0.f;
        }
        if (kind == K_CONV && l == 0 && b == 0) {
            for (int it = gw; it < NB * MEML * DEPTH; it += NGW) { const int m = it & 511, ll = it >> 9, bb = m >> 8, jr = m & 255;
                const bf16_t* src = MKVRAW + (size_t)m * 4096 + ll * 1024;
#pragma unroll
                for (int i = 0; i < 2; ++i) { const int c = lane + 64 * i, head = c >> 5, part = (c >> 4) & 1, d0 = (c & 15) * 8;
                    const u32x4 w = *(const u32x4*)(src + c * 8);
                    float ss = sumsq8(w); ss = sum16(ss);
                    const float rs = rsqrtf(ss * (1.f / 128.f) + EPS);
                    const float* gk = p.mem_k_g + ll * 128 + d0;
                    u32x4 o = w;
                    if (part == 0) { o.x = cvtpk(bflo(w.x) * rs * gk[0], bfhi(w.x) * rs * gk[1]); o.y = cvtpk(bflo(w.y) * rs * gk[2], bfhi(w.y) * rs * gk[3]);
                                     o.z = cvtpk(bflo(w.z) * rs * gk[4], bfhi(w.z) * rs * gk[5]); o.w = cvtpk(bflo(w.w) * rs * gk[6], bfhi(w.w) * rs * gk[7]); }
                    const size_t hb = (size_t)((ll * 2 + bb) * 4 + head) * 256 * 128;
                    bf16_t* dst = (part == 0) ? MK + hb + (size_t)jr * 128 + d0 : MV + hb + (size_t)jr * 128 + d0;
                    *(u32x4*)dst = o; }
            }
        }
        if (kind == K_ROWS) {
            rows_to_bf16(xin, XB, RSTD, SEQ, gw, NGW, lane);
            if (bx == 0 && tid < 16) KQMAX[tid] = 0.f;
        } else if (kind == K_CONV) {
            const float* cw = p.conv_w + l * 3 * 512; const float* cbv = p.conv_b + l * 512; const float* mqg = p.mem_q_g + l * 128;
            const int c0 = lane * 8;
            const f32x4 w0a = *(const f32x4*)(cw + c0), w0b = *(const f32x4*)(cw + c0 + 4), w1a = *(const f32x4*)(cw + 512 + c0), w1b = *(const f32x4*)(cw + 512 + c0 + 4);
            const f32x4 w2a = *(const f32x4*)(cw + 1024 + c0), w2b = *(const f32x4*)(cw + 1024 + c0 + 4), bia = *(const f32x4*)(cbv + c0), bib = *(const f32x4*)(cbv + c0 + 4);
            const f32x4 gqa = *(const f32x4*)(mqg + (lane & 15) * 8), gqb = *(const f32x4*)(mqg + (lane & 15) * 8 + 4);
            const float W0[8] = {w0a.x, w0a.y, w0a.z, w0a.w, w0b.x, w0b.y, w0b.z, w0b.w}, W1[8] = {w1a.x, w1a.y, w1a.z, w1a.w, w1b.x, w1b.y, w1b.z, w1b.w};
            const float W2[8] = {w2a.x, w2a.y, w2a.z, w2a.w, w2b.x, w2b.y, w2b.z, w2b.w}, BI[8] = {bia.x, bia.y, bia.z, bia.w, bib.x, bib.y, bib.z, bib.w};
            const float gq[8] = {gqa.x, gqa.y, gqa.z, gqa.w, gqb.x, gqb.y, gqb.z, gqb.w};
            for (int t = gw; t < SEQ; t += NGW) {
                bf16_t* pr = PROJ + (size_t)t * PJ;
                const u32x4 z4 = (u32x4){0u, 0u, 0u, 0u};
                const u32x4 cc0 = *(const u32x4*)(pr + C_CC + c0), cu0 = *(const u32x4*)(pr + C_CU + c0);
                const u32x4 ccm = t > 0 ? *(const u32x4*)(pr - PJ + C_CC + c0) : z4, cum = t > 0 ? *(const u32x4*)(pr - PJ + C_CU + c0) : z4;
                const u32x4 ccp = t < SEQ - 1 ? *(const u32x4*)(pr + PJ + C_CC + c0) : z4, cup = t < SEQ - 1 ? *(const u32x4*)(pr + PJ + C_CU + c0) : z4;
                const u32x4 cb = *(const u32x4*)(pr + C_CB + c0), gc = *(const u32x4*)(pr + C_GCONV + c0);
                const u32x4 qm = *(const u32x4*)(pr + C_QMEM + c0);
                u32x4 oc;
#pragma unroll
                for (int i = 0; i < 4; ++i) {
                    const float lo_ = bflo(cb[i]) * (W0[2 * i] * bflo(ccm[i]) * bflo(cum[i]) + W1[2 * i] * bflo(cc0[i]) * bflo(cu0[i]) + W2[2 * i] * bflo(ccp[i]) * bflo(cup[i]) + BI[2 * i]) * bflo(gc[i]);
                    const float hi_ = bfhi(cb[i]) * (W0[2 * i + 1] * bfhi(ccm[i]) * bfhi(cum[i]) + W1[2 * i + 1] * bfhi(cc0[i]) * bfhi(cu0[i]) + W2[2 * i + 1] * bfhi(ccp[i]) * bfhi(cup[i]) + BI[2 * i + 1]) * bfhi(gc[i]);
                    oc[i] = cvtpk(lo_, hi_);
                }
                *(u32x4*)(pr + C_CB + c0) = oc;
                float ss = sumsq8(qm); ss = sum16(ss);
                const float rs = rsqrtf(ss * (1.f / 128.f) + EPS);
                u32x4 oq; oq.x = cvtpk(bflo(qm.x) * rs * gq[0], bfhi(qm.x) * rs * gq[1]); oq.y = cvtpk(bflo(qm.y) * rs * gq[2], bfhi(qm.y) * rs * gq[3]);
                oq.z = cvtpk(bflo(qm.z) * rs * gq[4], bfhi(qm.z) * rs * gq[5]); oq.w = cvtpk(bflo(qm.w) * rs * gq[6], bfhi(qm.w) * rs * gq[7]);
                *(u32x4*)(pr + C_QMEM + c0) = oq;
            }
        } else if (kind == K_QKV) {
            const float* qg = p.q_head_g + l * 96; const float* kg = p.k_head_g + l * 96;
            const int h = lane >> 3, j = lane & 7;
            const float if0 = p.inv_freq[2 * j], if1 = p.inv_freq[2 * j + 1];
            const f32x4 qga = *(const f32x4*)(qg + 8 * j), qgb = *(const f32x4*)(qg + 8 * j + 4), kga = *(const f32x4*)(kg + 8 * j), kgb = *(const f32x4*)(kg + 8 * j + 4);
            const float QG[8] = {qga.x, qga.y, qga.z, qga.w, qgb.x, qgb.y, qgb.z, qgb.w}, KG[8] = {kga.x, kga.y, kga.z, kga.w, kgb.x, kgb.y, kgb.z, kgb.w};
            const float qr0 = qg[64 + 2 * j], qr1 = qg[65 + 2 * j], qr2 = qg[80 + 2 * j], qr3 = qg[81 + 2 * j];
            const float kr0 = kg[64 + 2 * j], kr1 = kg[65 + 2 * j], kr2 = kg[80 + 2 * j], kr3 = kg[81 + 2 * j];
            constexpr float CQ = 0.10206207261596575f * 1.4426950408889634f;
            float qmax2 = 0.f, kmax2 = 0.f;
            for (int t = gw; t < SEQ; t += NGW) {
                const bf16_t* pr = PROJ + (size_t)t * PJ;
                float sq = 0.f, skv = 0.f;
                if (lane < 48) sq = sumsq8(*(const u32x4*)(pr + C_QLAT + lane * 8));
                if (lane < 32) skv = sumsq8(*(const u32x4*)(pr + C_KVLAT + lane * 8));
                sq = wave_sum(sq); skv = wave_sum(skv);
                const float rq = rsqrtf(sq * (1.f / 384.f) + EPS), rkv = rsqrtf(skv * (1.f / 256.f) + EPS);
                const float pf = (float)p.pos[b * SEQ + t];
                const float a0 = pf * if0, a1 = pf * if1;
                const double r0 = (double)a0 * 0.15915494309189535, r1 = (double)a1 * 0.15915494309189535;
                const float f0 = (float)(r0 - rint(r0)), f1 = (float)(r1 - rint(r1));
                const float c0 = __builtin_amdgcn_cosf(f0), s0 = __builtin_amdgcn_sinf(f0), c1 = __builtin_amdgcn_cosf(f1), s1 = __builtin_amdgcn_sinf(f1);
                {
                    const bf16_t* qp = QRAW + (size_t)t * 768 + h * 96;
                    const u32x4 qn = *(const u32x4*)(qp + 8 * j); const unsigned qa = *(const unsigned*)(qp + 64 + 2 * j), qb = *(const unsigned*)(qp + 80 + 2 * j);
                    float v0 = bflo(qn.x) * rq, v1 = bfhi(qn.x) * rq, v2 = bflo(qn.y) * rq, v3 = bfhi(qn.y) * rq, v4 = bflo(qn.z) * rq, v5 = bfhi(qn.z) * rq, v6 = bflo(qn.w) * rq, v7 = bfhi(qn.w) * rq;
                    float t10 = bflo(qa) * rq, t11 = bfhi(qa) * rq, t20 = bflo(qb) * rq, t21 = bfhi(qb) * rq;
                    float ss = (v0 * v0 + v1 * v1) + (v2 * v2 + v3 * v3) + (v4 * v4 + v5 * v5) + (v6 * v6 + v7 * v7) + (t10 * t10 + t11 * t11) + (t20 * t20 + t21 * t21);
                    ss = sum8(ss);
                    const float rh = rsqrtf(ss * (1.f / 96.f) + EPS);
                    const float rc = rh * CQ;
                    v0 *= rc * QG[0]; v1 *= rc * QG[1]; v2 *= rc * QG[2]; v3 *= rc * QG[3]; v4 *= rc * QG[4]; v5 *= rc * QG[5]; v6 *= rc * QG[6]; v7 *= rc * QG[7];
                    t10 *= rc * qr0; t11 *= rc * qr1; t20 *= rc * qr2; t21 *= rc * qr3;
                    float n2 = (v0 * v0 + v1 * v1) + (v2 * v2 + v3 * v3) + (v4 * v4 + v5 * v5) + (v6 * v6 + v7 * v7) + (t10 * t10 + t11 * t11) + (t20 * t20 + t21 * t21);
                    n2 = sum8(n2);
                    qmax2 = fmaxf(qmax2, n2); if (j == 0) QN[(size_t)t * 8 + h] = sqrtf(n2);
                    u32x4 o; o.x = cvtpk(v0, v1); o.y = cvtpk(v2, v3); o.z = cvtpk(v4, v5); o.w = cvtpk(v6, v7);
                    bf16_t* qo = QF + (size_t)t * 768 + h * 96;
                    *(u32x4*)(qo + 8 * j) = o;
                    *(unsigned*)(qo + 64 + 2 * j) = cvtpk(t10 * c0 - t20 * s0, t11 * c1 - t21 * s1);
                    *(unsigned*)(qo + 80 + 2 * j) = cvtpk(t20 * c0 + t10 * s0, t21 * c1 + t11 * s1);
                }
                {
                    const bf16_t* kp = KVRAW + (size_t)t * 1024 + h * 128;
                    const u32x4 kn = *(const u32x4*)(kp + 8 * j), vv = *(const u32x4*)(kp + 64 + 8 * j);
                    const unsigned ka = *(const unsigned*)(pr + C_KPE + 2 * j), kb = *(const unsigned*)(pr + C_KPE + 16 + 2 * j);
                    float v0 = bflo(kn.x) * rkv, v1 = bfhi(kn.x) * rkv, v2 = bflo(kn.y) * rkv, v3 = bfhi(kn.y) * rkv, v4 = bflo(kn.z) * rkv, v5 = bfhi(kn.z) * rkv, v6 = bflo(kn.w) * rkv, v7 = bfhi(kn.w) * rkv;
                    float t10 = bflo(ka), t11 = bfhi(ka), t20 = bflo(kb), t21 = bfhi(kb);
                    float ss = (v0 * v0 + v1 * v1) + (v2 * v2 + v3 * v3) + (v4 * v4 + v5 * v5) + (v6 * v6 + v7 * v7) + (t10 * t10 + t11 * t11) + (t20 * t20 + t21 * t21);
                    ss = sum8(ss);
                    const float rh = rsqrtf(ss * (1.f / 96.f) + EPS);
                    v0 *= rh * KG[0]; v1 *= rh * KG[1]; v2 *= rh * KG[2]; v3 *= rh * KG[3]; v4 *= rh * KG[4]; v5 *= rh * KG[5]; v6 *= rh * KG[6]; v7 *= rh * KG[7];
                    t10 *= rh * kr0; t11 *= rh * kr1; t20 *= rh * kr2; t21 *= rh * kr3;
                    float n2 = (v0 * v0 + v1 * v1) + (v2 * v2 + v3 * v3) + (v4 * v4 + v5 * v5) + (v6 * v6 + v7 * v7) + (t10 * t10 + t11 * t11) + (t20 * t20 + t21 * t21);
                    n2 = sum8(n2);
                    kmax2 = fmaxf(kmax2, n2);
                    u32x4 o; o.x = cvtpk(v0, v1); o.y = cvtpk(v2, v3); o.z = cvtpk(v4, v5); o.w = cvtpk(v6, v7);
                    bf16_t* ko = KF + ((size_t)h * SEQ + t) * 96;
                    *(u32x4*)(ko + 8 * j) = o;
                    *(unsigned*)(ko + 64 + 2 * j) = cvtpk(t10 * c0 - t20 * s0, t11 * c1 - t21 * s1);
                    *(unsigned*)(ko + 80 + 2 * j) = cvtpk(t20 * c0 + t10 * s0, t21 * c1 + t11 * s1);
                    u32x4 ov; ov.x = cvtpk(bflo(vv.x) * rkv, bfhi(vv.x) * rkv); ov.y = cvtpk(bflo(vv.y) * rkv, bfhi(vv.y) * rkv); ov.z = cvtpk(bflo(vv.z) * rkv, bfhi(vv.z) * rkv); ov.w = cvtpk(bflo(vv.w) * rkv, bfhi(vv.w) * rkv);
                    *(u32x4*)(VF + ((size_t)h * SEQ + t) * 64 + 8 * j) = ov;
                }
            }
            {
                LAS float* red = (LAS float*)ldsl;
                if (j == 0) { red[wave * 16 + h] = qmax2; red[wave * 16 + 8 + h] = kmax2; }
                __syncthreads();
                if (tid < 16) { float mx = 0.f;
#pragma unroll
                    for (int w = 0; w < NWAVES; ++w) mx = fmaxf(mx, red[w * 16 + tid]);
                    atomicMax((unsigned*)KQMAX + tid, __float_as_uint(mx)); }
            }
        } else if (kind == K_MATT) {
#ifndef NO_MATT
            for (int u = bx; u < 4 * (SEQ / 256); u += G) { const int hm = u & 3, qb = u >> 2;
                const size_t kvoff = ((size_t)((l * 2 + b) * 4 + hm) * 256) * 128;
                att::attn_mem<PJ, PJ>(PROJ + (size_t)qb * 256 * PJ + C_QMEM + hm * 128, MK + kvoff, MV + kvoff, PROJ + (size_t)qb * 256 * PJ + C_GMEM + hm * 128, (char*)lds, tid);
            }
#endif
        } else if (kind == K_ATT) {
#ifndef NO_ATT
            { int tf = tid; asm volatile("" : "+v"(tf));
              for (int u = bx; u < NH * (SEQ / 256); u += G) { const int hh = u & 7, qb = u >> 3;
                const float kmx = sqrtf(KQMAX[8 + hh]), qmx = sqrtf(KQMAX[hh]);
                if (qmx * kmx <= 60.f)
                    att::attn_dma4<768, PJ>(QF + (size_t)qb * 256 * 768 + hh * 96, KF + (size_t)hh * SEQ * 96, VF + (size_t)hh * SEQ * 64,
                                       PROJ + (size_t)qb * 256 * PJ + C_GATTN + hh * 64, SEQ, (char*)lds, tf, QN + (size_t)qb * 256 * 8 + hh, kmx,
                                       (u == bx) || (G & 7) != 0, (u + G < NH * (SEQ / 256)) && (G & 7) == 0);
              } }
            { int ts = tid; asm volatile("" : "+v"(ts));
              for (int u = bx; u < NH * (SEQ / 256); u += G) { const int hh = u & 7, qb = u >> 3;
                const float kmx = sqrtf(KQMAX[8 + hh]), qmx = sqrtf(KQMAX[hh]);
                if (!(qmx * kmx <= 60.f))
                    att::attn_unit<96, 64, 1, 768, PJ, true, false>(QF + (size_t)qb * 256 * 768 + hh * 96, KF + (size_t)hh * SEQ * 96, VF + (size_t)hh * SEQ * 64,
                                       PROJ + (size_t)qb * 256 * PJ + C_GATTN + hh * 64, SEQ, (char*)lds, ts, nullptr, 0.f);
              } }
#endif
        }
#endif
        __syncthreads();
        if (sync_after && st + 1 < hi) { if (lo < 0) grid.sync(); else xcd_barrier(xbar); }
    }
}

extern "C" void kernel_launch(void* const* d_in, const int* in_sizes, int n_in, void* d_out, int out_size, void* d_ws, size_t ws_size, hipStream_t stream) {
    static int grid = 0;
    if (grid == 0) {
        if (n_in != 22 || in_sizes[0] != NB * SEQ * DM || out_size != NB * SEQ * DM || ws_size < WS_END) {
            fprintf(stderr, "kernel_launch: shape/workspace mismatch: n_in %d in0 %d out %d ws %zu (need %zu)\n", n_in, n_in > 0 ? in_sizes[0] : -1, out_size, ws_size, (size_t)WS_END); grid = -1; return; }
        int dev = 0, cus = 0, per_cu = 0;
        if (hipGetDevice(&dev) != hipSuccess || hipDeviceGetAttribute(&cus, hipDeviceAttributeMultiprocessorCount, dev) != hipSuccess) { grid = -1; return; }
        if (hipFuncSetAttribute((const void*)mega, hipFuncAttributeMaxDynamicSharedMemorySize, LDS_BYTES) != hipSuccess) { fprintf(stderr, "kernel_launch: hipFuncSetAttribute failed\n"); grid = -1; return; }
        if (hipOccupancyMaxActiveBlocksPerMultiprocessor(&per_cu, (const void*)mega, NWAVES * 64, LDS_BYTES) != hipSuccess || per_cu < 1) { fprintf(stderr, "kernel_launch: occupancy query gave %d\n", per_cu); per_cu = 1; }
        (void)hipGetLastError();
        grid = cus * 1;
    }
    if (grid < 0) return;
    Params p{};
    p.x = (const float*)d_in[0]; p.mem = (const float*)d_in[1]; p.pos = (const int*)d_in[2];
    p.norm_g = (const float*)d_in[3]; p.w_in = (const float*)d_in[4]; p.b_gate = (const float*)d_in[5]; p.q_norm_g = (const float*)d_in[6]; p.w_uq = (const float*)d_in[7];
    p.kv_norm_g = (const float*)d_in[8]; p.w_ukv = (const float*)d_in[9]; p.q_head_g = (const float*)d_in[10]; p.k_head_g = (const float*)d_in[11]; p.conv_w = (const float*)d_in[12];
    p.conv_b = (const float*)d_in[13]; p.mem_norm_g = (const float*)d_in[14]; p.w_mkv = (const float*)d_in[15]; p.mem_q_g = (const float*)d_in[16]; p.mem_k_g = (const float*)d_in[17];
    p.w_br_attn = (const float*)d_in[18]; p.w_br_conv = (const float*)d_in[19]; p.w_br_mem = (const float*)d_in[20]; p.w_out = (const float*)d_in[21];
    p.out = (float*)d_out; p.ws = (unsigned char*)d_ws;
    for (int i = 0; i < 16; ++i) p.inv_freq[i] = (float)pow(10000.0, -(double)i / 16.0);
    if (hipMemsetAsync((char*)d_ws + WS_BAR, 0, 16384, stream) != hipSuccess) { fprintf(stderr, "kernel_launch: memset failed\n"); return; }
#if MK_MULTI
    for (int st = 0; st < N_STEPS;) { int e = st;
        for (;;) { const bool sy = (e < 3) ? true : step_sync((e - 3) % STEPS_PER); ++e; if (sy || e >= N_STEPS) break; }
        hipLaunchKernelGGL(mega, dim3(grid), dim3(NWAVES * 64), LDS_BYTES, stream, p, st, e); st = e; }
#else
    int lo = 0, hi = N_STEPS;
    void* args[] = {&p, &lo, &hi};
    const hipError_t e = hipLaunchCooperativeKernel((const void*)mega, dim3(grid), dim3(NWAVES * 64), args, LDS_BYTES, stream);
    if (e != hipSuccess) fprintf(stderr, "kernel_launch: cooperative launch failed: %s (grid %d)\n", hipGetErrorString(e), grid);
#endif
}
```
